# Optimizing an MI355X kernel written in HIP

```python
import math
import jax, jax.numpy as jnp
from jax import lax
import numpy as np

D_MODEL = 2048
BATCH = 2
SEQ = 4096
DEPTH = 4

HEAD_DIM = 128
GRID_W = 64
BLOCK = 128
EPS = 1e-6
A_HEADS = 8
NA_ROWS = 8
NA_COLS = 16
B_Q_HEADS = 8
B_KV_HEADS = 2
AXIAL_THETA = 10000.0
C_Q_HEADS = 12
C_KV_HEADS = 4
C_WINDOW = 128
C_SIDE_BLOCKS = -(-C_WINDOW // BLOCK)
D_DILATIONS = ((128, 1), (512, 4), (2048, 16))
D_GROUPS = len(D_DILATIONS)
D_SLOTS = 4
D_Q_HEADS = D_GROUPS * D_SLOTS
ROPE_THETA = 500000.0
ROPE_DIMS = HEAD_DIM // 4
FFN_HIDDEN = ((-(-8 * D_MODEL // 3)) + 255) // 256 * 256
N_EVEN = (DEPTH + 1) // 2
N_ODD = DEPTH // 2
AB_IN = (3 * A_HEADS + B_Q_HEADS + 2 * B_KV_HEADS) * HEAD_DIM
AB_OUT = (A_HEADS + B_Q_HEADS) * HEAD_DIM
CD_IN = (C_Q_HEADS + 2 * C_KV_HEADS + D_Q_HEADS + 2 * D_SLOTS) * HEAD_DIM
CD_OUT = (C_Q_HEADS + D_SLOTS) * HEAD_DIM

kernel_name = "hybrid_natten_axial_window_dilated_encoder"


def rms_norm(x, g):
    xf = x.astype(jnp.float32)
    y = xf * lax.rsqrt(jnp.mean(xf * xf, axis=-1, keepdims=True) + EPS)
    return (y * g.astype(jnp.float32)).astype(x.dtype)


def rope(x, pos, theta):
    r = x.shape[-1]
    half = r // 2
    inv = jnp.exp(-math.log(theta) * jnp.arange(half, dtype=jnp.float32) * (2.0 / r))
    ang = pos.astype(jnp.float32)[:, None] * inv[None, :]
    cos, sin = jnp.cos(ang), jnp.sin(ang)
    xf = x.astype(jnp.float32)
    x1, x2 = xf[..., :half], xf[..., half:]
    return jnp.concatenate([x1 * cos - x2 * sin, x1 * sin + x2 * cos], axis=-1).astype(x.dtype)


def partial_rope(x, pos):
    return jnp.concatenate([rope(x[..., :ROPE_DIMS], pos, ROPE_THETA), x[..., ROPE_DIMS:]], axis=-1)


def axial_rope(x, rows, cols):
    h = HEAD_DIM // 2
    return jnp.concatenate([rope(x[..., :h], rows, AXIAL_THETA), rope(x[..., h:], cols, AXIAL_THETA)], axis=-1)


def split_cols(h, widths):
    outs, start = [], 0
    for w in widths:
        outs.append(h[..., start:start + w])
        start += w
    return outs


def split_heads(h):
    b, s, c = h.shape
    return h.reshape(b, s, c // HEAD_DIM, HEAD_DIM).transpose(0, 2, 1, 3)


def merge_heads(o):
    b, n, s, dh = o.shape
    return o.transpose(0, 2, 1, 3).reshape(b, s, n * dh)


def neighbourhood_attention(q, k, v, rpb):
    b, h, s, dh = q.shape
    rows = s // GRID_W
    kr = min(NA_ROWS, rows)
    qg = q.reshape(b, h, rows, GRID_W, dh)
    kg = k.reshape(b, h, rows, GRID_W, dh)
    vg = v.reshape(b, h, rows, GRID_W, dh)
    cols = jnp.arange(GRID_W)
    col_start = jnp.clip(cols - NA_COLS // 2, 0, GRID_W - NA_COLS)
    col_idx = col_start[:, None] + jnp.arange(NA_COLS)[None, :]
    dc = col_idx - cols[:, None]
    scale = dh ** -0.5

    def row_block(r):
        r0 = jnp.clip(r - kr // 2, 0, rows - kr)
        kb = lax.dynamic_slice_in_dim(kg, r0, kr, axis=2)
        vb = lax.dynamic_slice_in_dim(vg, r0, kr, axis=2)
        kn = kb[:, :, :, col_idx]
        vn = vb[:, :, :, col_idx]
        qr = lax.dynamic_index_in_dim(qg, r, axis=2, keepdims=False)
        logits = jnp.einsum('bhwd,bhiwjd->bhwij', qr, kn,
                            preferred_element_type=jnp.float32) * scale
        dr = r0 + jnp.arange(kr) - r
        bias = rpb[:, dr[:, None, None] + NA_ROWS - 1, dc[None, :, :] + NA_COLS - 1]
        logits = logits + bias.transpose(0, 2, 1, 3)[None].astype(jnp.float32)
        p = jax.nn.softmax(logits.reshape(b, h, GRID_W, kr * NA_COLS), axis=-1)
        p = p.reshape(b, h, GRID_W, kr, NA_COLS).astype(v.dtype)
        return jnp.einsum('bhwij,bhiwjd->bhwd', p, vn)

    out = lax.map(row_block, jnp.arange(rows))
    return out.transpose(1, 2, 0, 3, 4).reshape(b, h, s, dh)


def dense_gqa(q, k, v):
    b, hq, s, dh = q.shape
    hkv = k.shape[1]
    g = hq // hkv
    nb = s // BLOCK
    scale = dh ** -0.5
    qb = q.reshape(b, hkv, g, nb, BLOCK, dh).transpose(3, 0, 1, 2, 4, 5)

    def blk(qi):
        logits = jnp.einsum('bkgqd,bksd->bkgqs', qi, k, preferred_element_type=jnp.float32) * scale
        p = jax.nn.softmax(logits, axis=-1).astype(v.dtype)
        return jnp.einsum('bkgqs,bksd->bkgqd', p, v)

    out = lax.map(blk, qb)
    return out.transpose(1, 2, 3, 0, 4, 5).reshape(b, hq, s, dh)


def window_gqa_sink(q, k, v, sink):
    b, hq, s, dh = q.shape
    hkv = k.shape[1]
    g = hq // hkv
    nb = s // BLOCK
    n_side = C_SIDE_BLOCKS
    n_band = 2 * n_side + 1
    scale = dh ** -0.5

    def band(t):
        tp = jnp.pad(t, ((0, 0), (0, 0), (n_side * BLOCK, n_side * BLOCK), (0, 0)))
        tb = tp.reshape(b, hkv, nb + 2 * n_side, BLOCK, dh)
        return jnp.concatenate([tb[:, :, j:j + nb] for j in range(n_band)], axis=3)

    kb, vb = band(k), band(v)
    qb = q.reshape(b, hkv, g, nb, BLOCK, dh)
    logits = jnp.einsum('bkgnqd,bknjd->bkgnqj', qb, kb,
                        preferred_element_type=jnp.float32) * scale
    blk = jnp.arange(nb)[:, None, None] * BLOCK
    qpos = blk + jnp.arange(BLOCK)[None, :, None]
    kpos = blk - n_side * BLOCK + jnp.arange(n_band * BLOCK)[None, None, :]
    valid = (jnp.abs(kpos - qpos) <= C_WINDOW) & (kpos >= 0) & (kpos < s)
    logits = jnp.where(valid, logits, -jnp.inf)
    sink_l = jnp.broadcast_to(sink.astype(jnp.float32).reshape(1, hkv, g, 1, 1, 1), logits.shape[:-1] + (1,))
    p = jax.nn.softmax(jnp.concatenate([logits, sink_l], axis=-1), axis=-1)[..., :-1]
    out = jnp.einsum('bkgnqj,bknjd->bkgnqd', p.astype(v.dtype), vb)
    return out.reshape(b, hq, s, dh)


def dilated_attention(q, k, v):
    b, _, s, dh = q.shape
    nb = s // BLOCK
    scale = dh ** -0.5
    offsets = []
    for w, d in D_DILATIONS:
        half = (w // 2) // d
        offsets.append(d * jnp.arange(-half, half + 1))
    qb = q.reshape(b, D_GROUPS, D_SLOTS, nb, BLOCK, dh).transpose(3, 0, 1, 2, 4, 5)

    def blk(args):
        i, qi = args
        t = i * BLOCK + jnp.arange(BLOCK)
        ms, dens, nums = [], [], []
        for gi, off in enumerate(offsets):
            idx = t[:, None] + off[None, :]
            valid = (idx >= 0) & (idx < s)
            idc = jnp.clip(idx, 0, s - 1)
            kg = k[:, :, idc]
            vg = v[:, :, idc]
            logits = jnp.einsum('bnqd,bnqjd->bnqj', qi[:, gi], kg,
                                preferred_element_type=jnp.float32) * scale
            logits = jnp.where(valid, logits, -jnp.inf)
            m = jnp.max(logits, axis=-1, keepdims=True)
            p = jnp.exp(logits - m)
            ms.append(m)
            dens.append(jnp.sum(p, axis=-1, keepdims=True))
            nums.append(jnp.einsum('bnqj,bnqjd->bnqd', p, vg.astype(jnp.float32)))
        m_all = jnp.max(jnp.stack(ms), axis=0)
        num = sum(jnp.exp(m - m_all) * n for m, n in zip(ms, nums))
        den = sum(jnp.exp(m - m_all) * dd for m, dd in zip(ms, dens))
        return (num / den).astype(v.dtype)

    out = lax.map(blk, (jnp.arange(nb), qb))
    return out.transpose(1, 2, 0, 3, 4).reshape(b, D_SLOTS, s, dh)


def mixer_ab(xn, w_in, w_out, a_qn, a_kn, a_rpb, b_qn, b_kn):
    s = xn.shape[1]
    h = xn @ w_in
    qa, ka, va, qb, kb, vb = [split_heads(t) for t in split_cols(
        h, [A_HEADS * HEAD_DIM] * 3 + [B_Q_HEADS * HEAD_DIM, B_KV_HEADS * HEAD_DIM, B_KV_HEADS * HEAD_DIM])]
    oa = neighbourhood_attention(rms_norm(qa, a_qn), rms_norm(ka, a_kn), va, a_rpb)
    pos = jnp.arange(s)
    rows, cols = pos // GRID_W, pos % GRID_W
    qb = axial_rope(rms_norm(qb, b_qn), rows, cols)
    kb = axial_rope(rms_norm(kb, b_kn), rows, cols)
    ob = dense_gqa(qb, kb, vb)
    return jnp.concatenate([merge_heads(oa), merge_heads(ob)], axis=-1) @ w_out


def mixer_cd(xn, w_in, w_out, c_qn, c_kn, c_sink, d_qn, d_kn):
    s = xn.shape[1]
    h = xn @ w_in
    qc, kc, vc, qd, kd, vd = [split_heads(t) for t in split_cols(
        h, [C_Q_HEADS * HEAD_DIM, C_KV_HEADS * HEAD_DIM, C_KV_HEADS * HEAD_DIM,
            D_Q_HEADS * HEAD_DIM, D_SLOTS * HEAD_DIM, D_SLOTS * HEAD_DIM])]
    pos = jnp.arange(s)
    oc = window_gqa_sink(partial_rope(rms_norm(qc, c_qn), pos), partial_rope(rms_norm(kc, c_kn), pos), vc, c_sink)
    od = dilated_attention(partial_rope(rms_norm(qd, d_qn), pos), partial_rope(rms_norm(kd, d_kn), pos), vd)
    return jnp.concatenate([merge_heads(oc), merge_heads(od)], axis=-1) @ w_out


def swiglu(xn, w_gate, w_up, w_down):
    return (jax.nn.silu(xn @ w_gate) * (xn @ w_up)) @ w_down


def setup_inputs(seed: int = 0) -> dict:
    key = jax.random.key(seed)
    ks = jax.random.split(key, 20)
    nrm = lambda k, shape, sc: jax.random.normal(k, shape, jnp.float32) * sc
    gain = lambda k, shape: 1.0 + 0.05 * jax.random.normal(k, shape, jnp.float32)
    return {
        "x": nrm(ks[0], (BATCH, SEQ, D_MODEL), 1.0),
        "attn_norm": gain(ks[1], (DEPTH, D_MODEL)),
        "ffn_norm": gain(ks[2], (DEPTH, D_MODEL)),
        "ab_w_in": nrm(ks[3], (N_EVEN, D_MODEL, AB_IN), D_MODEL ** -0.5),
        "ab_w_out": nrm(ks[4], (N_EVEN, AB_OUT, D_MODEL), AB_OUT ** -0.5),
        "a_q_norm": gain(ks[5], (N_EVEN, HEAD_DIM)),
        "a_k_norm": gain(ks[6], (N_EVEN, HEAD_DIM)),
        "a_rpb": nrm(ks[7], (N_EVEN, A_HEADS, 2 * NA_ROWS - 1, 2 * NA_COLS - 1), 0.5),
        "b_q_norm": gain(ks[8], (N_EVEN, HEAD_DIM)),
        "b_k_norm": gain(ks[9], (N_EVEN, HEAD_DIM)),
        "cd_w_in": nrm(ks[10], (N_ODD, D_MODEL, CD_IN), D_MODEL ** -0.5),
        "cd_w_out": nrm(ks[11], (N_ODD, CD_OUT, D_MODEL), CD_OUT ** -0.5),
        "c_q_norm": gain(ks[12], (N_ODD, HEAD_DIM)),
        "c_k_norm": gain(ks[13], (N_ODD, HEAD_DIM)),
        "c_sink": nrm(ks[14], (N_ODD, C_Q_HEADS), 0.5),
        "d_q_norm": gain(ks[15], (N_ODD, HEAD_DIM)),
        "d_k_norm": gain(ks[16], (N_ODD, HEAD_DIM)),
        "w_gate": nrm(ks[17], (DEPTH, D_MODEL, FFN_HIDDEN), D_MODEL ** -0.5),
        "w_up": nrm(ks[18], (DEPTH, D_MODEL, FFN_HIDDEN), D_MODEL ** -0.5),
        "w_down": nrm(ks[19], (DEPTH, FFN_HIDDEN, D_MODEL), FFN_HIDDEN ** -0.5),
    }


def reference(x, attn_norm, ffn_norm, ab_w_in, ab_w_out, a_q_norm, a_k_norm, a_rpb, b_q_norm, b_k_norm,
              cd_w_in, cd_w_out, c_q_norm, c_k_norm, c_sink, d_q_norm, d_k_norm, w_gate, w_up, w_down):
    for layer in range(DEPTH):
        j = layer // 2
        xn = rms_norm(x, attn_norm[layer])
        if layer % 2 == 0:
            x = x + mixer_ab(xn, ab_w_in[j], ab_w_out[j], a_q_norm[j], a_k_norm[j], a_rpb[j],
                             b_q_norm[j], b_k_norm[j])
        else:
            x = x + mixer_cd(xn, cd_w_in[j], cd_w_out[j], c_q_norm[j], c_k_norm[j], c_sink[j],
                             d_q_norm[j], d_k_norm[j])
        x = x + swiglu(rms_norm(x, ffn_norm[layer]), w_gate[layer], w_up[layer], w_down[layer])
    return x
```

```cpp
#include <hip/hip_runtime.h>
#include <hip/hip_bf16.h>
#include <hip/hip_cooperative_groups.h>
#include <cstdio>
#include <cstring>
#include <cstdint>
namespace cg = cooperative_groups;
__device__ __forceinline__ int otid() { int t = threadIdx.x; asm volatile("" : "+v"(t)); return t; }
__device__ __forceinline__ int obid() { int t = blockIdx.x; asm volatile("" : "+s"(t)); return t; }
__device__ __forceinline__ int ogdim() { int t = gridDim.x; asm volatile("" : "+s"(t)); return t; }

constexpr int DM = 2048, SEQ = 4096, NTOK = 8192, DEPTH = 4;
constexpr int AB_IN = 4608, CD_IN = 5120, FFN = 5632;
constexpr float EPS = 1e-6f;

__device__ const double kInvRevAx[32] = {0.15915494309189535, 0.11934937021124886, 0.089499401608891013, 0.067115083005227255, 0.050329212104487035, 0.037741584717419771, 0.028302195830623399, 0.02122365276477766, 0.015915494309189534, 0.011934937021124886, 0.0089499401608891024, 0.0067115083005227253, 0.0050329212104487037, 0.0037741584717419772, 0.0028302195830623399, 0.0021223652764777662, 0.0015915494309189536, 0.0011934937021124885, 0.00089499401608891024, 0.0006711508300522726, 0.00050329212104487033, 0.00037741584717419774, 0.00028302195830623395, 0.00021223652764777661, 0.00015915494309189535, 0.00011934937021124886, 8.9499401608891018e-05, 6.7115083005227254e-05, 5.0329212104487035e-05, 3.7741584717419777e-05, 2.8302195830623396e-05, 2.1223652764777659e-05};
__device__ const double kInvRevPr[16] = {0.15915494309189535, 0.070086521587798503, 0.03086376340470123, 0.013591370636193905, 0.0059851857127137054, 0.002635675898667414, 0.001160663641240061, 0.00051111750453754386, 0.00022507907903927653, 9.9117309369019355e-05, 4.3647952792802891e-05, 1.9221100684944863e-05, 8.4643308082414014e-06, 3.7274086019153519e-06, 1.6414262627950345e-06, 7.2282930688328648e-07};

struct Params {
  const float *x, *attn_norm, *ffn_norm, *ab_w_in, *ab_w_out, *a_qn, *a_kn, *a_rpb, *b_qn, *b_kn,
              *cd_w_in, *cd_w_out, *c_qn, *c_kn, *c_sink, *d_qn, *d_kn, *w_gate, *w_up, *w_down;
  float* xres;
  unsigned short *wt_in, *wt_out, *wt_gu, *wt_dn;
  unsigned short *xb, *h, *ao, *hid, *dpart;
  float *dml; unsigned long long* sumsq; float *tab_ax, *tab_pr;
};
constexpr size_t WT_IN_L = (size_t)CD_IN * DM, WT_OUT_L = (size_t)DM * DM, WT_GU_L = (size_t)2 * FFN * DM, WT_DN_L = (size_t)DM * FFN;

namespace pg8 {
#define PG8_LAS __attribute__((address_space(3)))
typedef unsigned short bf16_t;
typedef short bf16x8 __attribute__((ext_vector_type(8)));
typedef float f32x4 __attribute__((ext_vector_type(4)));
typedef unsigned u32x4 __attribute__((ext_vector_type(4)));
constexpr int BM = 256, BK = 64, HALF = 128, HTB = HALF * BK * 2  , STAGE_BYTES = 8 * HTB, NXCD = 8, WGM = 8;

__host__ __device__ __forceinline__ int lds_byte(int r, int c) { const int st = (r >> 4) * 2 + (c >> 5), rr = r & 15, cc = c & 31, ob = rr * 64 + cc * 2; return st * 1024 + (ob ^ (((ob >> 9) & 1) << 5)); }
__host__ __device__ __forceinline__ void stage_rc(int b, int& R, int& C) { const int st = b / 1024, sb = b % 1024, swz = sb ^ (((sb >> 9) & 1) << 5); R = (st >> 1) * 16 + swz / 64; C = (st & 1) * 32 + (swz % 64) / 2; }
__host__ __device__ __forceinline__ int perm32(int rho) { const int n = rho >> 4, i = rho & 15; return 8 * (i >> 2) + 4 * n + (i & 3); }

struct Unit { int pm, pn; };
struct Gemm { const bf16_t* A; const bf16_t* Bt; int M, N, K; };

struct StaticOrder {
    int nM, nN, nwg, G, c;
    __host__ __device__ void init(int M, int N, int G_, int c_) { nM = M / BM; nN = N / BM; nwg = nM * nN; G = G_; c = c_; }
    __host__ __device__ bool next(int i, Unit& u) const {
        const long L = (long)i * G + c; if (L >= nwg) return false;
        int wgid = (int)L; { const int q = nwg / NXCD, r = nwg % NXCD, xcd = wgid % NXCD, off = wgid / NXCD; wgid = (xcd < r ? xcd * (q + 1) : r * (q + 1) + (xcd - r) * q) + off; }
        const int nig = WGM * nN, gid = wgid / nig, fm = gid * WGM, gsz = (nM - fm) < WGM ? (nM - fm) : WGM;
        u.pm = fm + ((wgid % nig) % gsz); u.pn = (wgid % nig) / gsz; return true;
    }
    __device__ __forceinline__ void a_ready(const Unit&) const {}
    __device__ __forceinline__ void done(const Unit&) const {}
};

__device__ __forceinline__ unsigned cvt_pk_bf16(float lo, float hi) { unsigned r; asm volatile("v_cvt_pk_bf16_f32 %0, %1, %2" : "=v"(r) : "v"(lo), "v"(hi)); return r; }

struct EpiH {
    static constexpr bool PERM = true, AFTER_DRAIN = false;
    bf16_t* O; int ldc; const unsigned long long* ss;
    __device__ __forceinline__ void operator()(const f32x4 (&acc)[2][2][4][2], const Unit& u, int wr, int wc, int fr, int fq) const {
        const int row0 = u.pm * BM + wr * 64 + fr, col0 = u.pn * BM + wc * 32 + 8 * fq;
#pragma unroll
        for (int ai = 0; ai < 2; ++ai)
#pragma unroll
            for (int m = 0; m < 4; ++m) { const int row = row0 + ai * HALF + m * 16; const float rs = __builtin_amdgcn_rsqf((float)ss[row] * (1.0f / (2048.0f * 16777216.0f)) + 1e-6f);
                bf16_t* rowp = O + (size_t)row * ldc + col0;
#pragma unroll
                for (int bj = 0; bj < 2; ++bj) { const f32x4 v0 = acc[ai][bj][m][0] * rs, v1 = acc[ai][bj][m][1] * rs;
                    u32x4 w = {cvt_pk_bf16(v0[0], v0[1]), cvt_pk_bf16(v0[2], v0[3]), cvt_pk_bf16(v1[0], v1[1]), cvt_pk_bf16(v1[2], v1[3])};
                    *(u32x4*)(rowp + bj * HALF) = w; } }
    }
};
struct EpiGU {
    static constexpr bool PERM = true, AFTER_DRAIN = false;
    bf16_t* O; const unsigned long long* ss;
    __device__ __forceinline__ void operator()(const f32x4 (&acc)[2][2][4][2], const Unit& u, int wr, int wc, int fr, int fq) const {
        const int row0 = u.pm * BM + wr * 64 + fr, col0 = u.pn * HALF + wc * 32 + 8 * fq;
#pragma unroll
        for (int ai = 0; ai < 2; ++ai)
#pragma unroll
            for (int m = 0; m < 4; ++m) { const int row = row0 + ai * HALF + m * 16; const float rs = __builtin_amdgcn_rsqf((float)ss[row] * (1.0f / (2048.0f * 16777216.0f)) + 1e-6f);
                float o[8];
#pragma unroll
                for (int n = 0; n < 2; ++n)
#pragma unroll
                    for (int j = 0; j < 4; ++j) { const float g = acc[ai][0][m][n][j] * rs, up = acc[ai][1][m][n][j] * rs;
                        const float sg = g * __builtin_amdgcn_rcpf(1.0f + __builtin_amdgcn_exp2f(-1.4426950408889634f * g)); o[n * 4 + j] = sg * up; }
                u32x4 w = {cvt_pk_bf16(o[0], o[1]), cvt_pk_bf16(o[2], o[3]), cvt_pk_bf16(o[4], o[5]), cvt_pk_bf16(o[6], o[7])};
                *(u32x4*)(O + (size_t)row * 5632 + col0) = w; }
    }
};
struct EpiRes {
    static constexpr bool PERM = true, AFTER_DRAIN = false;
    float* X; bf16_t* XB; unsigned long long* ssn;
    __device__ __forceinline__ void operator()(const f32x4 (&acc)[2][2][4][2], const Unit& u, int wr, int wc, int fr, int fq) const {
        const int row0 = u.pm * BM + wr * 64 + fr, col0 = u.pn * BM + wc * 32 + 8 * fq;
#pragma unroll
        for (int ai = 0; ai < 2; ++ai)
#pragma unroll
            for (int m = 0; m < 4; ++m) { const int row = row0 + ai * HALF + m * 16; float part = 0.f;
                float* xr = X + (size_t)row * 2048 + col0; bf16_t* br = XB + (size_t)row * 2048 + col0;
#pragma unroll
                for (int bj = 0; bj < 2; ++bj) { f32x4 a = *(const f32x4*)(xr + bj * HALF), b = *(const f32x4*)(xr + bj * HALF + 4);
                    a += acc[ai][bj][m][0]; b += acc[ai][bj][m][1];
                    *(f32x4*)(xr + bj * HALF) = a; *(f32x4*)(xr + bj * HALF + 4) = b;
                    u32x4 w = {cvt_pk_bf16(a[0], a[1]), cvt_pk_bf16(a[2], a[3]), cvt_pk_bf16(b[0], b[1]), cvt_pk_bf16(b[2], b[3])};
                    *(u32x4*)(br + bj * HALF) = w;
                    part += a[0] * a[0] + a[1] * a[1] + a[2] * a[2] + a[3] * a[3] + b[0] * b[0] + b[1] * b[1] + b[2] * b[2] + b[3] * b[3]; }
                part += __shfl_xor(part, 16); part += __shfl_xor(part, 32);
                if (ssn != nullptr && fq == 0) atomicAdd(ssn + row, (unsigned long long)(part * 16777216.0f)); }
    }
};
template <class Epi, class Sched, bool STAMP = false>
__device__ __forceinline__ void gemm_phase(PG8_LAS unsigned char* lds, const Gemm g, const Sched& S, const Epi& E, unsigned long long* stamps) {
    const int tid = otid(), wid = __builtin_amdgcn_readfirstlane(tid >> 6), lane = tid & 63, wr = wid >> 2, wc = wid & 3, fr = lane & 15, fq = lane >> 4;
    const int K = g.K, nt = K / BK;
    int ts_lo = 0, ts_hi = 0, nts = 0; const unsigned long long rt_entry = STAMP ? (unsigned long long)wall_clock64() : 0ull;
#define PG8_STAMP() do { if (STAMP && wid == 0 && nts < 64) { const unsigned long long _c = (unsigned long long)clock64(); \
        ts_lo = (lane == nts) ? (int)(unsigned)_c : ts_lo; ts_hi = (lane == nts) ? (int)(unsigned)(_c >> 32) : ts_hi; ++nts; } } while (0)
    PG8_STAMP();
    unsigned voffA[2], voffB[2];
#pragma unroll
    for (int i = 0; i < 2; ++i) { int R, C; stage_rc(tid * 16 + i * 8192, R, C); const int Rb = Epi::PERM ? ((R & ~31) + perm32(R & 31)) : R;
        voffA[i] = (unsigned)(R * K + C) * 2u; voffB[i] = (unsigned)(Rb * K + C) * 2u; }
    const size_t kstep = (size_t)(BK * 2);
    const size_t hstep = (size_t)HALF * K * 2;
    const size_t tstep = 2 * hstep;
    const unsigned ldsw = (unsigned)wid * 1024u;
    const int aoff = lds_byte(wr * 64 + fr, fq * 8), boff = lds_byte(wc * 32 + fr, fq * 8);
#define PG8_SA(b, h) (((b) * 2 + (h)) * HTB)
#define PG8_SB(b, h) ((4 + (b) * 2 + (h)) * HTB)
#define PG8_STAGE(bufoff, gbase, voff) do { _Pragma("unroll") for (int _i = 0; _i < 2; ++_i) \
        __builtin_amdgcn_global_load_lds((const unsigned*)((const char*)(gbase) + (voff)[_i]), (PG8_LAS unsigned*)(lds + (bufoff) + ldsw + _i * 8192), 16, 0, 0); } while (0)
#define PG8_LDA(dst, b, h) do { _Pragma("unroll") for (int m = 0; m < 4; ++m) _Pragma("unroll") for (int k = 0; k < 2; ++k) dst[m][k] = *(const PG8_LAS bf16x8*)(lds + PG8_SA(b, h) + aoff + m * 2048 + k * 1024); } while (0)
#define PG8_LDB(dst, b, h) do { _Pragma("unroll") for (int n = 0; n < 2; ++n) _Pragma("unroll") for (int k = 0; k < 2; ++k) dst[n][k] = *(const PG8_LAS bf16x8*)(lds + PG8_SB(b, h) + boff + n * 2048 + k * 1024); } while (0)
#define PG8_MMA(ai, bj, At, Bt) do { __builtin_amdgcn_s_setprio(1); _Pragma("unroll") for (int m = 0; m < 4; ++m) _Pragma("unroll") for (int n = 0; n < 2; ++n) _Pragma("unroll") for (int k = 0; k < 2; ++k) \
        acc[ai][bj][m][n] = __builtin_amdgcn_mfma_f32_16x16x32_bf16(Bt[n][k], At[m][k], acc[ai][bj][m][n], 0, 0, 0); __builtin_amdgcn_s_setprio(0); } while (0)
#define PG8_WAIT_V(n) asm volatile("s_waitcnt vmcnt(" #n ")" ::: "memory")
#define PG8_WAIT_L(n) asm volatile("s_waitcnt lgkmcnt(" #n ")" ::: "memory")
#define PG8_BAR __builtin_amdgcn_s_barrier()
#define PG8_SCHED __builtin_amdgcn_sched_barrier(0)
    Unit cur, nxt; int ui = 0;
    if (!S.next(0, cur)) return;
    f32x4 acc[2][2][4][2];
#pragma unroll
    for (int a = 0; a < 2; ++a)
#pragma unroll
        for (int b = 0; b < 2; ++b)
#pragma unroll
            for (int m = 0; m < 4; ++m)
#pragma unroll
                for (int n = 0; n < 2; ++n) acc[a][b][m][n] = (f32x4){0.f, 0.f, 0.f, 0.f};
    bf16x8 At[4][2], B0[2][2], B1[2][2];
    const char* cA = (const char*)g.A + (size_t)cur.pm * tstep; const char* cB = (const char*)g.Bt + (size_t)cur.pn * tstep;
    S.a_ready(cur);
    PG8_STAGE(PG8_SB(0, 0), cB, voffB); PG8_STAGE(PG8_SA(0, 0), cA, voffA); PG8_STAGE(PG8_SB(0, 1), cB + hstep, voffB); PG8_STAGE(PG8_SA(0, 1), cA + hstep, voffA);
    if (wr == 1) PG8_BAR;
    PG8_WAIT_V(4); PG8_BAR;
    PG8_STAGE(PG8_SB(1, 0), cB + kstep, voffB); PG8_STAGE(PG8_SA(1, 0), cA + kstep, voffA); PG8_STAGE(PG8_SB(1, 1), cB + hstep + kstep, voffB);
    PG8_WAIT_V(6); PG8_BAR;
    PG8_STAMP();
    for (;;) {
        const bool has_next = S.next(ui + 1, nxt);
        const char* nA = has_next ? (const char*)g.A + (size_t)nxt.pm * tstep : cA; const char* nB = has_next ? (const char*)g.Bt + (size_t)nxt.pn * tstep : cB;
        for (int t = 0; t < nt; t += 2) {
            const bool last = (t == nt - 2);
            const char* a1 = cA + (size_t)(t + 1) * kstep;
            const char* a2 = last ? nA : cA + (size_t)(t + 2) * kstep; const char* b2 = last ? nB : cB + (size_t)(t + 2) * kstep;
            const char* a3 = a2 + kstep; const char* b3 = b2 + kstep;
            if (last && has_next) S.a_ready(nxt);
            PG8_LDB(B0, 0, 0); PG8_SCHED; PG8_LDA(At, 0, 0); PG8_STAGE(PG8_SA(1, 1), a1 + hstep, voffA);
            PG8_WAIT_L(8); PG8_BAR; PG8_WAIT_L(0); PG8_MMA(0, 0, At, B0); PG8_BAR; PG8_SCHED;
            PG8_LDB(B1, 0, 1); PG8_STAGE(PG8_SB(0, 0), b2, voffB);
            PG8_BAR; PG8_WAIT_L(0); PG8_MMA(0, 1, At, B1); PG8_BAR;
            PG8_LDA(At, 0, 1); PG8_STAGE(PG8_SA(0, 0), a2, voffA);
            PG8_BAR; PG8_WAIT_L(0); PG8_MMA(1, 0, At, B0); PG8_BAR; PG8_SCHED;
            PG8_STAGE(PG8_SB(0, 1), b2 + hstep, voffB);
            PG8_WAIT_V(6); PG8_BAR; PG8_MMA(1, 1, At, B1); PG8_BAR;
            PG8_LDB(B0, 1, 0); PG8_SCHED; PG8_LDA(At, 1, 0); PG8_STAGE(PG8_SA(0, 1), a2 + hstep, voffA);
            PG8_WAIT_L(8); PG8_BAR; PG8_WAIT_L(0); PG8_MMA(0, 0, At, B0); PG8_BAR; PG8_SCHED;
            PG8_LDB(B1, 1, 1); PG8_STAGE(PG8_SB(1, 0), b3, voffB);
            PG8_BAR; PG8_WAIT_L(0); PG8_MMA(0, 1, At, B1); PG8_BAR;
            PG8_LDA(At, 1, 1); PG8_STAGE(PG8_SA(1, 0), a3, voffA);
            PG8_BAR; PG8_WAIT_L(0); PG8_MMA(1, 0, At, B0); PG8_BAR; PG8_SCHED;
            PG8_STAGE(PG8_SB(1, 1), b3 + hstep, voffB);
            PG8_WAIT_V(6); PG8_BAR; PG8_MMA(1, 1, At, B1); PG8_BAR;
        }
        PG8_STAMP();
        if constexpr (!Epi::AFTER_DRAIN) { E(acc, cur, wr, wc, fr, fq); S.done(cur); }
        PG8_STAMP();
        if (!has_next) break;
#pragma unroll
        for (int a = 0; a < 2; ++a)
#pragma unroll
            for (int b = 0; b < 2; ++b)
#pragma unroll
                for (int m = 0; m < 4; ++m)
#pragma unroll
                    for (int n = 0; n < 2; ++n) acc[a][b][m][n] = (f32x4){0.f, 0.f, 0.f, 0.f};
        cur = nxt; cA = nA; cB = nB; ++ui;
    }
    PG8_WAIT_V(0);
    if (wr == 0) PG8_BAR;
    PG8_BAR;
    if constexpr (Epi::AFTER_DRAIN) { E.fused(acc, cur, wr, wc, fr, fq, lds, wid, lane); S.done(cur); }
    PG8_STAMP();
    if (STAMP && wid == 0) { stamps[lane] = lane < nts ? (((unsigned long long)(unsigned)ts_hi << 32) | (unsigned)ts_lo) : 0ull;
        if (lane == 62) stamps[62] = rt_entry; if (lane == 63) stamps[63] = (unsigned long long)wall_clock64(); }
#undef PG8_STAMP
#undef PG8_SA
#undef PG8_SB
#undef PG8_STAGE
#undef PG8_LDA
#undef PG8_LDB
#undef PG8_MMA
#undef PG8_WAIT_V
#undef PG8_WAIT_L
#undef PG8_BAR
#undef PG8_SCHED
}
}

namespace at {
using bf16 = __hip_bfloat16;
constexpr int D = 128, NW = 8, QBLK = 32, KVBLK = 64;
constexpr float SCALE = 0.088388347648318440f;
constexpr float THR = 8.f;
constexpr size_t SHM_V = KVBLK * D * 2, SHM_K = KVBLK * D * 2, SHM_ATTN = 2 * SHM_V + 2 * SHM_K + NW * 64 * 4;
using bf16x8 = __attribute__((ext_vector_type(8))) short;
using s16x4  = __attribute__((ext_vector_type(4))) short;
using f32x16 = __attribute__((ext_vector_type(16))) float;
using u32x4  = __attribute__((ext_vector_type(4))) unsigned;
#define KSWZ(row, colB) ((row) * 256 + ((colB) ^ (((row) & 7) << 4)))
#define SBAR() __builtin_amdgcn_sched_barrier(0)
__device__ __forceinline__ int crow(int r, int hi) { return (r & 3) + 8 * (r >> 2) + 4 * hi; }
__device__ __forceinline__ unsigned cvtpk(float lo, float hi) {
  unsigned r; asm volatile("v_cvt_pk_bf16_f32 %0, %1, %2" : "=v"(r) : "v"(lo), "v"(hi)); return r;
}
struct PolNone { __device__ __forceinline__ void apply(f32x16&, f32x16&, int, int) const {} };
struct PolWin {
  int qp, kb0, W;
  __device__ __forceinline__ void apply(f32x16& p0, f32x16& p1, int t, int hi) const {
    const int base = kb0 + 64 * t - qp + 4 * hi + W; const unsigned lim = 2u * (unsigned)W;
#pragma unroll
    for (int r = 0; r < 16; ++r) { const int d0 = base + (r & 3) + 8 * (r >> 2);
      p0[r] = ((unsigned)d0 > lim) ? -INFINITY : p0[r]; p1[r] = ((unsigned)(d0 + 32) > lim) ? -INFINITY : p1[r]; }
  }
};
struct PolNA {
  int r, c, rstart; const float* rpb;
  __device__ __forceinline__ void apply(f32x16& p0, f32x16& p1, int t, int hi) const {
    const int rho = rstart + t; const int r0 = min(max(r - 4, 0), 56), c0 = min(max(c - 8, 0), 48);
    const bool rv = (rho >= r0) && (rho < r0 + 8);
    const int bbase = rv ? (rho - r + 7) * 31 + 15 - c : 15 - c;
    constexpr float ISC = 11.313708498984761f;
#pragma unroll
    for (int rr = 0; rr < 16; ++rr) { const int k0 = (rr & 3) + 8 * (rr >> 2) + 4 * hi, k1 = k0 + 32;
      const bool v0 = rv && ((unsigned)(k0 - c0) < 16u), v1 = rv && ((unsigned)(k1 - c0) < 16u);
      const float b0 = rpb[v0 ? bbase + k0 : 0], b1 = rpb[v1 ? bbase + k1 : 0];
      p0[rr] = v0 ? fmaf(b0, ISC, p0[rr]) : -INFINITY; p1[rr] = v1 ? fmaf(b1, ISC, p1[rr]) : -INFINITY; }
  }
};
template <class Pol>
__device__ __forceinline__ void partialSM(f32x16& p0, f32x16& p1, float& m_reg, float& mn, float& alpha, const Pol& pol, int tile, int hi) {
  constexpr float C = SCALE * 1.4426950408889634f;
  pol.apply(p0, p1, tile, hi);
  float pmax = p0[0];
#pragma unroll
  for (int r = 1; r < 16; ++r) pmax = fmaxf(pmax, p0[r]);
#pragma unroll
  for (int r = 0; r < 16; ++r) pmax = fmaxf(pmax, p1[r]);
  { auto rr = __builtin_amdgcn_permlane32_swap(__float_as_uint(pmax), __float_as_uint(pmax), false, false);
    pmax = fmaxf(__uint_as_float(rr[0]), __uint_as_float(rr[1])); }
  if (__builtin_expect(__all(pmax - m_reg <= THR / SCALE), 1)) { mn = m_reg; alpha = 1.f; }
  else { mn = fmaxf(m_reg, pmax); alpha = __builtin_amdgcn_exp2f((m_reg - mn) * C); m_reg = mn; }
  float mnC = -mn * C;
#pragma unroll
  for (int r = 0; r < 16; ++r) p0[r] = fmaf(p0[r], C, mnC);
#pragma unroll
  for (int r = 0; r < 16; ++r) p1[r] = fmaf(p1[r], C, mnC);
#pragma unroll
  for (int r = 0; r < 16; ++r) p0[r] = __builtin_amdgcn_exp2f(p0[r]);
}
__device__ __forceinline__ void finishSM(f32x16& p0, f32x16& p1, float alpha, float& l_reg, bf16x8& pa0, bf16x8& pa1, bf16x8& pa2, bf16x8& pa3) {
#pragma unroll
  for (int r = 0; r < 16; ++r) p1[r] = __builtin_amdgcn_exp2f(p1[r]);
  float ps = 0;
#pragma unroll
  for (int r = 0; r < 16; ++r) ps += p0[r];
#pragma unroll
  for (int r = 0; r < 16; ++r) ps += p1[r];
  { auto rr = __builtin_amdgcn_permlane32_swap(__float_as_uint(ps), __float_as_uint(ps), false, false);
    ps = __uint_as_float(rr[0]) + __uint_as_float(rr[1]); }
  l_reg = l_reg * alpha + ps;
#define PK4(P, BASE, OUT) do { unsigned a0 = cvtpk(P[BASE + 0], P[BASE + 1]), a1 = cvtpk(P[BASE + 2], P[BASE + 3]);   \
    unsigned b0 = cvtpk(P[BASE + 4], P[BASE + 5]), b1 = cvtpk(P[BASE + 6], P[BASE + 7]);                              \
    auto r0 = __builtin_amdgcn_permlane32_swap(a0, b0, false, false); auto r1 = __builtin_amdgcn_permlane32_swap(a1, b1, false, false); \
    u32x4 w = {r0[0], r1[0], r0[1], r1[1]}; OUT = *reinterpret_cast<bf16x8*>(&w); } while (0)
  PK4(p0, 0, pa0); PK4(p0, 8, pa1); PK4(p1, 0, pa2); PK4(p1, 8, pa3);
#undef PK4
}
__device__ __forceinline__ void qkt(f32x16& p0, f32x16& p1, const bf16* Ks, const bf16x8* qr, int r32, int hi) {
  p0 = f32x16{}; p1 = f32x16{};
#pragma unroll
  for (int d0 = 0; d0 < 8; ++d0) { int cb = (d0 * 16 + hi * 8) * 2;
    bf16x8 b0 = *reinterpret_cast<const bf16x8*>((const char*)Ks + KSWZ(r32, cb));
    bf16x8 b1 = *reinterpret_cast<const bf16x8*>((const char*)Ks + KSWZ(32 + r32, cb));
    p0 = __builtin_amdgcn_mfma_f32_32x32x16_bf16(b0, qr[d0], p0, 0, 0, 0);
    p1 = __builtin_amdgcn_mfma_f32_32x32x16_bf16(b1, qr[d0], p1, 0, 0, 0); }
}
__device__ __forceinline__ int v_st(int k, int c) { const int kk = (k & ~0xC) | ((k & 4) << 1) | ((k & 8) >> 1); return ((kk >> 3) * 4 + (c >> 5)) * 512 + ((kk & 7) * 32 + (c & 31)) * 2; }
__device__ __forceinline__ int v_rd_base(int lane) { return ((lane & 3) << 3) | (((lane >> 2) & 3) << 6) | (((lane >> 4) & 1) << 5) | (((lane >> 5) & 1) << 8); }
constexpr int v_rd_off(int d0, int ks, int half) { return d0 * 512 + ks * 4096 + half * 2048; }
template <int OFF> __device__ __forceinline__ s16x4 tr_read(int vb) {
  s16x4 r; asm volatile("ds_read_b64_tr_b16 %0, %1 offset:%2" : "=&v"(r) : "v"(vb), "i"(OFF) : "memory"); return r;
}
template <int D0> __device__ __forceinline__ void pv_one(f32x16& od, int vb, bf16x8 pa0, bf16x8 pa1, bf16x8 pa2, bf16x8 pa3) {
  const s16x4 l0 = tr_read<v_rd_off(D0, 0, 0)>(vb), h0 = tr_read<v_rd_off(D0, 0, 1)>(vb), l1 = tr_read<v_rd_off(D0, 1, 0)>(vb), h1 = tr_read<v_rd_off(D0, 1, 1)>(vb);
  const s16x4 l2 = tr_read<v_rd_off(D0, 2, 0)>(vb), h2 = tr_read<v_rd_off(D0, 2, 1)>(vb), l3 = tr_read<v_rd_off(D0, 3, 0)>(vb), h3 = tr_read<v_rd_off(D0, 3, 1)>(vb);
  asm volatile("s_waitcnt lgkmcnt(0)" ::: "memory"); SBAR();
#define PK(L, H) (bf16x8){L[0], L[1], L[2], L[3], H[0], H[1], H[2], H[3]}
  od = __builtin_amdgcn_mfma_f32_32x32x16_bf16(pa0, PK(l0, h0), od, 0, 0, 0);
  od = __builtin_amdgcn_mfma_f32_32x32x16_bf16(pa1, PK(l1, h1), od, 0, 0, 0);
  od = __builtin_amdgcn_mfma_f32_32x32x16_bf16(pa2, PK(l2, h2), od, 0, 0, 0);
  od = __builtin_amdgcn_mfma_f32_32x32x16_bf16(pa3, PK(l3, h3), od, 0, 0, 0);
#undef PK
}
__device__ __forceinline__ void pv_d0(f32x16* o, int vb, bf16x8 pa0, bf16x8 pa1, bf16x8 pa2, bf16x8 pa3) {
  pv_one<0>(o[0], vb, pa0, pa1, pa2, pa3); pv_one<1>(o[1], vb, pa0, pa1, pa2, pa3); pv_one<2>(o[2], vb, pa0, pa1, pa2, pa3); pv_one<3>(o[3], vb, pa0, pa1, pa2, pa3);
}

template <class Pol, int ldq, int ldk, int ldo>
__device__ __forceinline__ void attn_body(const bf16* __restrict__ Qb, const bf16* __restrict__ Kh, const bf16* __restrict__ Vh,
                                          unsigned short* __restrict__ Ob, int NT, char* lds, const Pol& pol) {
  const float sink_l2 = -INFINITY; float* const ml = nullptr; const long ldml = 0;
  const int tid = otid(), wid = tid >> 6, lane = tid & 63, r32 = lane & 31, hi = lane >> 5;
  bf16* V_lds = (bf16*)lds; bf16* K_lds = (bf16*)(lds + 2 * SHM_V);
  float* ws = (float*)(lds + 2 * SHM_V + 2 * SHM_K) + wid * 64; float* li_l = ws; float* al_l = ws + 32;
  float m_reg = -1e30f, l_reg = 0; f32x16 o[4] = {}; bf16x8 qr[8];
  const bf16* Qw = Qb + (long)(wid * QBLK + r32) * ldq + hi * 8;
#pragma unroll
  for (int d0 = 0; d0 < 8; ++d0) qr[d0] = *reinterpret_cast<const bf16x8*>(Qw + d0 * 16);
  const int sr = tid >> 4, sc = (tid & 15) * 8, vst0 = v_st(sr, sc), vst1 = v_st(32 + sr, sc);
  const int vb0 = (int)(uintptr_t)V_lds + v_rd_base(lane);
  struct { bf16x8 vs0, vs1, ks0, ks1; } sr_[2];
#define SLOAD(i, k0) do { sr_[i].vs0 = *reinterpret_cast<const bf16x8*>(&Vh[(long)((k0) + sr) * ldk + sc]); sr_[i].vs1 = *reinterpret_cast<const bf16x8*>(&Vh[(long)((k0) + 32 + sr) * ldk + sc]); \
    sr_[i].ks0 = *reinterpret_cast<const bf16x8*>(&Kh[(long)((k0) + sr) * ldk + sc]); sr_[i].ks1 = *reinterpret_cast<const bf16x8*>(&Kh[(long)((k0) + 32 + sr) * ldk + sc]); } while (0)
#define SWRITE(b, i) do { *(bf16x8*)((char*)V_lds + (b) * SHM_V + vst0) = sr_[i].vs0;          \
    *(bf16x8*)((char*)V_lds + (b) * SHM_V + vst1) = sr_[i].vs1; int kc = sc * 2;               \
    *(bf16x8*)((char*)K_lds + (b) * SHM_K + KSWZ(sr, kc)) = sr_[i].ks0;                       \
    *(bf16x8*)((char*)K_lds + (b) * SHM_K + KSWZ(32 + sr, kc)) = sr_[i].ks1; } while (0)
#define SWAIT() asm volatile("s_waitcnt vmcnt(4)" ::: "memory")
#define RESC(a) do { if (__any((a) < 1.f)) { if (hi == 0) al_l[r32] = (a); asm volatile("s_waitcnt lgkmcnt(0)" ::: "memory"); \
    _Pragma("unroll") for (int d = 0; d < 4; ++d) _Pragma("unroll") for (int r = 0; r < 16; ++r) o[d][r] *= al_l[crow(r, hi)]; } } while (0)
  f32x16 pA0, pA1, pB0, pB1; float mnA, mnB, alA, alB; bf16x8 pa0, pa1, pa2, pa3;
  constexpr int SE = 0, SO = 1;
  SLOAD(SE, 0); asm volatile("s_waitcnt vmcnt(0)" ::: "memory"); SWRITE(0, SE); __syncthreads();
  qkt(pA0, pA1, K_lds, qr, r32, hi); partialSM(pA0, pA1, m_reg, mnA, alA, pol, 0, hi);
  SLOAD(SO, KVBLK); if (2 < NT) SLOAD(SE, 2 * KVBLK);
  SWAIT(); SWRITE(1, SO); __syncthreads();
  for (int j = 1; j + 1 < NT; j += 2) {
    SBAR(); qkt(pB0, pB1, (bf16*)((char*)K_lds + SHM_K), qr, r32, hi);
    finishSM(pA0, pA1, alA, l_reg, pa0, pa1, pa2, pa3); SBAR();
    SLOAD(SO, (j + 2) * KVBLK); SBAR();
    pv_d0(o, vb0, pa0, pa1, pa2, pa3); partialSM(pB0, pB1, m_reg, mnB, alB, pol, j, hi);
    __syncthreads(); SWAIT(); SWRITE(0, SE);
    RESC(alB); __syncthreads();
    SBAR(); qkt(pA0, pA1, K_lds, qr, r32, hi);
    finishSM(pB0, pB1, alB, l_reg, pa0, pa1, pa2, pa3); SBAR();
    if (j + 3 < NT) SLOAD(SE, (j + 3) * KVBLK); SBAR();
    pv_d0(o, vb0 + (int)SHM_V, pa0, pa1, pa2, pa3); partialSM(pA0, pA1, m_reg, mnA, alA, pol, j + 1, hi);
    __syncthreads(); SWAIT(); SWRITE(1, SO);
    RESC(alA); __syncthreads();
  }
  SBAR(); qkt(pB0, pB1, (bf16*)((char*)K_lds + SHM_K), qr, r32, hi);
  finishSM(pA0, pA1, alA, l_reg, pa0, pa1, pa2, pa3); SBAR();
  pv_d0(o, vb0, pa0, pa1, pa2, pa3); partialSM(pB0, pB1, m_reg, mnB, alB, pol, NT - 1, hi);
  __syncthreads(); RESC(alB);
  finishSM(pB0, pB1, alB, l_reg, pa0, pa1, pa2, pa3); SBAR();
  pv_d0(o, vb0 + (int)SHM_V, pa0, pa1, pa2, pa3);
  constexpr float C = SCALE * 1.4426950408889634f;
  if (ml != nullptr && hi == 0) { float* mp = ml + (long)(wid * QBLK + r32) * ldml; mp[0] = m_reg * C; mp[1] = l_reg; }
  l_reg += __builtin_amdgcn_exp2f(sink_l2 - m_reg * C);
  if (hi == 0) li_l[r32] = l_reg; asm volatile("s_waitcnt lgkmcnt(0)" ::: "memory");
  float rli[16];
#pragma unroll
  for (int r = 0; r < 16; ++r) rli[r] = __builtin_amdgcn_rcpf(li_l[crow(r, hi)]);
  unsigned short* Ow = Ob + (long)(wid * QBLK) * ldo;
#pragma unroll
  for (int r = 0; r < 16; ++r) { int orow = crow(r, hi);
#pragma unroll
    for (int d0 = 0; d0 < 4; ++d0) { const float v = o[d0][r] * rli[r]; Ow[(long)orow * ldo + d0 * 32 + r32] = (unsigned short)(cvtpk(v, v) & 0xffffu); } }
#undef SLOAD
#undef SWRITE
#undef SWAIT
#undef RESC
}
template <class Pol>
__device__ __forceinline__ void attn_body_simple(const bf16* __restrict__ Qb, long ldq, const bf16* __restrict__ Kh, const bf16* __restrict__ Vh, long ldk,
                                                 unsigned short* __restrict__ Ob, long ldo, int NT, char* lds, const Pol& pol, float sink_l2, float* ml, long ldml) {
  const int tid = otid(), wid = tid >> 6, lane = tid & 63, r32 = lane & 31, hi = lane >> 5;
  bf16* V_lds = (bf16*)lds; bf16* K_lds = (bf16*)(lds + 2 * SHM_V);
  float* ws = (float*)(lds + 2 * SHM_V + 2 * SHM_K) + wid * 64; float* li_l = ws; float* al_l = ws + 32;
  float m_reg = -1e30f, l_reg = 0; f32x16 o[4] = {}; bf16x8 qr[8];
  const bf16* Qw = Qb + (long)(wid * QBLK + r32) * ldq + hi * 8;
#pragma unroll
  for (int d0 = 0; d0 < 8; ++d0) qr[d0] = *reinterpret_cast<const bf16x8*>(Qw + d0 * 16);
  const int sr = tid >> 4, sc = (tid & 15) * 8, vst0 = v_st(sr, sc), vst1 = v_st(32 + sr, sc);
  const int vb0 = (int)(uintptr_t)V_lds + v_rd_base(lane);
  const bf16* kp = Kh + (long)sr * ldk + sc; const bf16* vp = Vh + (long)sr * ldk + sc; const long step32 = 32 * ldk, step64 = 64 * ldk;
  bf16x8 vs0, vs1, ks0, ks1;
#define LOADT() do { vs0 = *reinterpret_cast<const bf16x8*>(vp); vs1 = *reinterpret_cast<const bf16x8*>(vp + step32); \
    ks0 = *reinterpret_cast<const bf16x8*>(kp); ks1 = *reinterpret_cast<const bf16x8*>(kp + step32); kp += step64; vp += step64; } while (0)
#define WRITET(b) do { *(bf16x8*)((char*)V_lds + (b) * SHM_V + vst0) = vs0; *(bf16x8*)((char*)V_lds + (b) * SHM_V + vst1) = vs1; int kc = sc * 2; \
    *(bf16x8*)((char*)K_lds + (b) * SHM_K + KSWZ(sr, kc)) = ks0; *(bf16x8*)((char*)K_lds + (b) * SHM_K + KSWZ(32 + sr, kc)) = ks1; } while (0)
#define RESC(a) do { if (__any((a) < 1.f)) { if (hi == 0) al_l[r32] = (a); asm volatile("s_waitcnt lgkmcnt(0)" ::: "memory"); \
    _Pragma("unroll") for (int d = 0; d < 4; ++d) _Pragma("unroll") for (int r = 0; r < 16; ++r) o[d][r] *= al_l[crow(r, hi)]; } } while (0)
  LOADT(); WRITET(0);
  for (int t = 0; t < NT; ++t) {
    const int b = t & 1;
    __syncthreads();
    if (t + 1 < NT) LOADT();
    f32x16 p0, p1; float mn, al; bf16x8 pa0, pa1, pa2, pa3;
    qkt(p0, p1, (const bf16*)((const char*)K_lds + b * SHM_K), qr, r32, hi);
    partialSM(p0, p1, m_reg, mn, al, pol, t, hi);
    RESC(al);
    finishSM(p0, p1, al, l_reg, pa0, pa1, pa2, pa3); SBAR();
    pv_d0(o, vb0 + b * (int)SHM_V, pa0, pa1, pa2, pa3);
    if (t + 1 < NT) WRITET(b ^ 1);
  }
  constexpr float C = SCALE * 1.4426950408889634f;
  if (ml != nullptr && hi == 0) { float* mp = ml + (long)(wid * QBLK + r32) * ldml; mp[0] = m_reg * C; mp[1] = l_reg; }
  l_reg += __builtin_amdgcn_exp2f(sink_l2 - m_reg * C);
  if (hi == 0) li_l[r32] = l_reg; asm volatile("s_waitcnt lgkmcnt(0)" ::: "memory");
  float rli[16];
#pragma unroll
  for (int r = 0; r < 16; ++r) rli[r] = __builtin_amdgcn_rcpf(li_l[crow(r, hi)]);
  unsigned short* Ow = Ob + (long)(wid * QBLK) * ldo;
#pragma unroll
  for (int r = 0; r < 16; ++r) { int orow = crow(r, hi);
#pragma unroll
    for (int d0 = 0; d0 < 4; ++d0) { const float v = o[d0][r] * rli[r]; Ow[(long)orow * ldo + d0 * 32 + r32] = (unsigned short)(cvtpk(v, v) & 0xffffu); } }
#undef LOADT
#undef WRITET
#undef RESC
}
}

typedef unsigned short u16;
typedef unsigned u32x4_t __attribute__((ext_vector_type(4)));
constexpr int LDS_BYTES = 131072 + 4096;
__device__ __forceinline__ float bf2f(unsigned short v) { return __uint_as_float((unsigned)v << 16); }
__device__ __forceinline__ unsigned pk2(float a, float b) { return pg8::cvt_pk_bf16(a, b); }

__device__ __forceinline__ void transpose_tile(const float* __restrict__ src, int N, const float* __restrict__ gain, u16* __restrict__ dst, int K, int k0, int n0, int drow0, char* shm) {
  float* tile = (float*)shm;
  const int tid = otid();
  { const int rr = tid >> 4, cc = (tid & 15) * 4;
#pragma unroll
    for (int i = 0; i < 2; ++i) { const int kr = rr + 32 * i; const float4 v = *(const float4*)(src + (size_t)(k0 + kr) * N + n0 + cc);
      const float g = gain ? gain[k0 + kr] : 1.0f; float* tp = tile + kr * 65 + cc; tp[0] = v.x * g; tp[1] = v.y * g; tp[2] = v.z * g; tp[3] = v.w * g; } }
  __syncthreads();
  { const int n = tid >> 3, kk = (tid & 7) * 8; float v[8];
#pragma unroll
    for (int j = 0; j < 8; ++j) v[j] = tile[(kk + j) * 65 + n];
    u32x4_t w = {pk2(v[0], v[1]), pk2(v[2], v[3]), pk2(v[4], v[5]), pk2(v[6], v[7])};
    *(u32x4_t*)(dst + (size_t)(drow0 + n) * K + k0 + kk) = w; }
  __syncthreads();
}
__device__ __forceinline__ void transpose_job(const float* src, int K, int N, const float* gain, u16* dst, int mode, char* shm) {
  const int ntn = N / 64, ntiles = (K / 64) * ntn;
  for (int t = obid(); t < ntiles; t += ogdim()) { const int kt = t / ntn, nt = t - kt * ntn, n0 = nt * 64;
    const int drow0 = mode == 0 ? n0 : (256 * (n0 >> 7) + (n0 & 127) + (mode == 2 ? 128 : 0));
    transpose_tile(src, N, gain, dst - (size_t)0, K, kt * 64, n0, drow0 - 0, shm); }
}
__device__ __forceinline__ void phase_prologue(const Params& p, char* shm) {
  const int tid = otid(), bid = obid(), gdim = ogdim(), gtid = bid * 512 + tid, gsz = gdim * 512;
  for (int i = gtid; i < 7 * NTOK; i += gsz) p.sumsq[NTOK + i] = 0ull;
  for (int i = gtid; i < 64 * 32; i += gsz) { const int pos = i >> 5, f = i & 31; const double rev = (double)pos * kInvRevAx[f]; const float fr = (float)(rev - floor(rev));
    p.tab_ax[2 * i] = __builtin_amdgcn_cosf(fr); p.tab_ax[2 * i + 1] = __builtin_amdgcn_sinf(fr); }
  for (int i = gtid; i < SEQ * 16; i += gsz) { const int pos = i >> 4, f = i & 15; const double rev = (double)pos * kInvRevPr[f]; const float fr = (float)(rev - floor(rev));
    p.tab_pr[2 * i] = __builtin_amdgcn_cosf(fr); p.tab_pr[2 * i + 1] = __builtin_amdgcn_sinf(fr); }
  { const int wid = tid >> 6, lane = tid & 63;
    for (int row = bid * 8 + wid; row < NTOK; row += gdim * 8) { const float* xr = p.x + (size_t)row * DM; float* orow = p.xres + (size_t)row * DM; u16* brow = p.xb + (size_t)row * DM; float ss = 0.f;
#pragma unroll
      for (int i = 0; i < 4; ++i) { const int c = (i * 64 + lane) * 8; const float4 a = *(const float4*)(xr + c), b = *(const float4*)(xr + c + 4);
        *(float4*)(orow + c) = a; *(float4*)(orow + c + 4) = b;
        u32x4_t w = {pk2(a.x, a.y), pk2(a.z, a.w), pk2(b.x, b.y), pk2(b.z, b.w)}; *(u32x4_t*)(brow + c) = w;
        ss += a.x * a.x + a.y * a.y + a.z * a.z + a.w * a.w + b.x * b.x + b.y * b.y + b.z * b.z + b.w * b.w; }
#pragma unroll
      for (int s = 32; s >= 1; s >>= 1) ss += __shfl_xor(ss, s);
      if (lane == 0) p.sumsq[row] = (unsigned long long)(ss * 16777216.0f); } }
  for (int l = 0; l < DEPTH; ++l) { const int j = l >> 1; const bool odd = l & 1; const int nin = odd ? CD_IN : AB_IN;
    const float* win = odd ? p.cd_w_in + (size_t)j * DM * CD_IN : p.ab_w_in + (size_t)j * DM * AB_IN;
    const float* wout = odd ? p.cd_w_out + (size_t)j * DM * DM : p.ab_w_out + (size_t)j * DM * DM;
    transpose_job(win, DM, nin, p.attn_norm + l * DM, p.wt_in + l * WT_IN_L, 0, shm);
    transpose_job(wout, DM, DM, nullptr, p.wt_out + l * WT_OUT_L, 0, shm);
    transpose_job(p.w_gate + (size_t)l * DM * FFN, DM, FFN, p.ffn_norm + l * DM, p.wt_gu + l * WT_GU_L, 1, shm);
    transpose_job(p.w_up + (size_t)l * DM * FFN, DM, FFN, p.ffn_norm + l * DM, p.wt_gu + l * WT_GU_L, 2, shm);
    transpose_job(p.w_down + (size_t)l * FFN * DM, FFN, DM, nullptr, p.wt_dn + l * WT_DN_L, 0, shm); }
}

__device__ __forceinline__ void phase_qk(const Params& p, int l) {
  const int j = l >> 1; const bool odd = l & 1; const int nin = odd ? CD_IN : AB_IN, nh = odd ? 32 : 26;
  const int tid = otid(), lj = tid & 15; const long total = (long)NTOK * nh;
  for (long rid = (long)obid() * 32 + (tid >> 4); rid < total; rid += (long)ogdim() * 32) {
    const int tok = (int)(rid / nh), hx = (int)(rid - (long)tok * nh); int col, rope; const float* w;
    if (!odd) { if (hx < 8) { col = hx * 128; w = p.a_qn + j * 128; rope = 0; } else if (hx < 16) { col = 1024 + (hx - 8) * 128; w = p.a_kn + j * 128; rope = 0; }
                else if (hx < 24) { col = 3072 + (hx - 16) * 128; w = p.b_qn + j * 128; rope = 1; } else { col = 4096 + (hx - 24) * 128; w = p.b_kn + j * 128; rope = 1; } }
    else { rope = 2; if (hx < 12) { col = hx * 128; w = p.c_qn + j * 128; } else if (hx < 16) { col = 1536 + (hx - 12) * 128; w = p.c_kn + j * 128; }
           else if (hx < 28) { col = 2560 + (hx - 16) * 128; w = p.d_qn + j * 128; } else { col = 4096 + (hx - 28) * 128; w = p.d_kn + j * 128; } }
    u16* ptr = p.h + (size_t)tok * nin + col + lj * 8;
    const u32x4_t raw = *(const u32x4_t*)ptr; float v[8];
#pragma unroll
    for (int e = 0; e < 4; ++e) { v[2 * e] = __uint_as_float(raw[e] << 16); v[2 * e + 1] = __uint_as_float(raw[e] & 0xffff0000u); }
    float ss = 0.f;
#pragma unroll
    for (int e = 0; e < 8; ++e) ss += v[e] * v[e];
    ss += __shfl_xor(ss, 1); ss += __shfl_xor(ss, 2); ss += __shfl_xor(ss, 4); ss += __shfl_xor(ss, 8);
    const float rs = __builtin_amdgcn_rsqf(ss * (1.0f / 128.0f) + EPS);
    const float4 w0 = *(const float4*)(w + lj * 8), w1 = *(const float4*)(w + lj * 8 + 4);
    v[0] *= rs * w0.x; v[1] *= rs * w0.y; v[2] *= rs * w0.z; v[3] *= rs * w0.w; v[4] *= rs * w1.x; v[5] *= rs * w1.y; v[6] *= rs * w1.z; v[7] *= rs * w1.w;
    const int pos = tok & (SEQ - 1);
    const int px = (rope == 2) ? 2 : 4; float pv[8];
#pragma unroll
    for (int e = 0; e < 8; ++e) pv[e] = __shfl_xor(v[e], px);
    if (rope == 1) { const int hf = lj >> 3, jj = lj & 7; const int P = hf ? (pos & 63) : (pos >> 6); const bool second = jj >= 4; const int f0 = 8 * (jj & 3);
      const float* tb = p.tab_ax + (size_t)(P * 32 + f0) * 2;
#pragma unroll
      for (int e = 0; e < 8; ++e) { const float cs = tb[2 * e], sn = tb[2 * e + 1]; v[e] = second ? fmaf(pv[e], sn, v[e] * cs) : fmaf(-pv[e], sn, v[e] * cs); } }
    else if (rope == 2) { if (lj < 4) { const bool second = lj >= 2; const int f0 = 8 * (lj & 1); const float* tb = p.tab_pr + (size_t)(pos * 16 + f0) * 2;
#pragma unroll
      for (int e = 0; e < 8; ++e) { const float cs = tb[2 * e], sn = tb[2 * e + 1]; v[e] = second ? fmaf(pv[e], sn, v[e] * cs) : fmaf(-pv[e], sn, v[e] * cs); } } }
    u32x4_t o = {pk2(v[0], v[1]), pk2(v[2], v[3]), pk2(v[4], v[5]), pk2(v[6], v[7])}; *(u32x4_t*)ptr = o;
  }
}

__device__ __forceinline__ void phase_attn_even(const Params& p, int l, char* shm) {
  using at::bf16; const int j = l >> 1; const bf16* H = (const bf16*)p.h; const long LD = AB_IN;
  for (int it = obid(); it < 512; it += ogdim()) {
    __syncthreads();
#ifndef SUBSEL
#define SUBSEL 3
#endif
    if (it < 256) { if (SUBSEL & 1) {
      const int qb = it & 15, hq = (it >> 4) & 7, b = it >> 7; const long t0 = (long)b * SEQ;
      at::attn_body<at::PolNone, AB_IN, AB_IN, DM>(H + (t0 + qb * 256) * LD + 3072 + hq * 128, H + t0 * LD + 4096 + (hq >> 2) * 128, H + t0 * LD + 4352 + (hq >> 2) * 128,
                                 p.ao + (size_t)(t0 + qb * 256) * DM + 1024 + hq * 128, 64, shm, at::PolNone{});
    } } else if (SUBSEL & 2) {
      const int i2 = it - 256, R = i2 & 15, hh = (i2 >> 4) & 7, b = i2 >> 7; const long t0 = (long)b * SEQ;
      float* rl = (float*)(shm + at::SHM_ATTN); const float* rg = p.a_rpb + (size_t)(j * 8 + hh) * 465;
      const int tq = otid(); for (int i = tq; i < 465; i += 512) rl[i] = rg[i];
      const int qi = (tq >> 6) * 32 + (tq & 31); const int rstart = min(max(4 * R - 4, 0), 52);
      at::PolNA pol{4 * R + (qi >> 6), qi & 63, rstart, rl};
      at::attn_body_simple<at::PolNA>(H + (t0 + R * 256) * LD + hh * 128, LD, H + (t0 + rstart * 64) * LD + 1024 + hh * 128, H + (t0 + rstart * 64) * LD + 2048 + hh * 128, LD,
                               p.ao + (size_t)(t0 + R * 256) * DM + hh * 128, DM, 12, shm, pol, -INFINITY, nullptr, 0);
    }
  }
}
__device__ __forceinline__ void phase_attn_odd(const Params& p, int l, char* shm) {
  using at::bf16; const int j = l >> 1; const bf16* H = (const bf16*)p.h; const long LD = CD_IN;
  for (int it = obid(); it < 768; it += ogdim()) {
    __syncthreads();
    const int tq = otid(); const int qi = (tq >> 6) * 32 + (tq & 31);
    if (it < 384) {
      const int qb = it & 15, hq = (it >> 4) % 12, b = it / 192; const long t0 = (long)b * SEQ; const int q0 = qb * 256, ks = min(max(q0 - 128, 0), SEQ - 512), kv = hq / 3;
      at::PolWin pol{q0 + qi, ks, 128};
      at::attn_body_simple<at::PolWin>(H + (t0 + q0) * LD + hq * 128, LD, H + (t0 + ks) * LD + 1536 + kv * 128, H + (t0 + ks) * LD + 2048 + kv * 128, LD,
                                p.ao + (size_t)(t0 + q0) * DM + hq * 128, DM, 8, shm, pol, p.c_sink[j * 12 + hq] * 1.4426950408889634f, nullptr, 0);
    } else {
      const int i2 = it - 384, e = i2 & 15, g = (i2 >> 4) % 3, s = (i2 / 48) & 3, b = i2 / 192; const long t0 = (long)b * SEQ;
      const int d = g == 0 ? 1 : (g == 1 ? 4 : 16); const int rho = g == 0 ? 0 : (g == 1 ? (e >> 2) : e), ub = g == 0 ? e : (g == 1 ? (e & 3) : 0);
      const int sp = SEQ / d, u0 = ub * 256, nt = g == 2 ? 4 : 6, ks = min(max(u0 - 64, 0), sp - nt * 64);
      at::PolWin pol{u0 + qi, ks, 64};
      const long qtok = t0 + rho + (long)d * u0, ktok = t0 + rho + (long)d * ks;
      at::attn_body_simple<at::PolWin>(H + qtok * LD + 2560 + (g * 4 + s) * 128, LD * d, H + ktok * LD + 4096 + s * 128, H + ktok * LD + 4608 + s * 128, LD * d,
                                p.dpart + ((size_t)g * NTOK + qtok) * 512 + s * 128, 512L * d, nt, shm, pol, -INFINITY,
                                p.dml + (((size_t)g * NTOK + qtok) * 4 + s) * 2, 8L * d);
    }
  }
}
__device__ __forceinline__ void phase_merge(const Params& p) {
  const int tid = otid(), lj = tid & 15;
  for (int rid = obid() * 32 + (tid >> 4); rid < NTOK * 4; rid += ogdim() * 32) { const int tok = rid >> 2, s = rid & 3;
    float m[3], lg[3];
#pragma unroll
    for (int g = 0; g < 3; ++g) { const float2 v = *(const float2*)(p.dml + (((size_t)g * NTOK + tok) * 4 + s) * 2); m[g] = v.x; lg[g] = v.y; }
    const float M = fmaxf(m[0], fmaxf(m[1], m[2])); float w[3], ws = 0.f;
#pragma unroll
    for (int g = 0; g < 3; ++g) { w[g] = __builtin_amdgcn_exp2f(m[g] - M) * lg[g]; ws += w[g]; }
    const float inv = 1.0f / ws; float acc[8] = {0.f, 0.f, 0.f, 0.f, 0.f, 0.f, 0.f, 0.f};
#pragma unroll
    for (int g = 0; g < 3; ++g) { const u32x4_t raw = *(const u32x4_t*)(p.dpart + ((size_t)g * NTOK + tok) * 512 + s * 128 + lj * 8); const float wg = w[g] * inv;
#pragma unroll
      for (int e = 0; e < 4; ++e) { acc[2 * e] += wg * __uint_as_float(raw[e] << 16); acc[2 * e + 1] += wg * __uint_as_float(raw[e] & 0xffff0000u); } }
    u32x4_t o = {pk2(acc[0], acc[1]), pk2(acc[2], acc[3]), pk2(acc[4], acc[5]), pk2(acc[6], acc[7])};
    *(u32x4_t*)(p.ao + (size_t)tok * DM + 1536 + s * 128 + lj * 8) = o; }
}

template <class Epi> __device__ __forceinline__ void run_gemm(const u16* A, const u16* Bt, int N, int K, const Epi& E, char* shm) {
  pg8::Gemm g{A, Bt, NTOK, N, K}; pg8::StaticOrder S; S.init(NTOK, N, ogdim(), obid());
  pg8::gemm_phase<Epi, pg8::StaticOrder, false>((PG8_LAS unsigned char*)shm, g, S, E, nullptr);
}

constexpr int NPHASE = 1 + 7 * DEPTH;
__global__ void __launch_bounds__(512) mega(Params p, int ph0, int ph1) {
  extern __shared__ __attribute__((aligned(16))) char shm[];
  cg::grid_group grid = cg::this_grid();
  bool first = true;
  for (int ph = ph0; ph < ph1; ++ph) {
    const int l = (ph - 1) / 7, sub = (ph - 1) % 7; const bool odd = l & 1;
    if (ph > 0 && sub == 3 && !odd) continue;
    if (!first) grid.sync();
    first = false;
#ifndef ONLY
#define ONLY -1
#endif
#define EN(k) (ONLY < 0 || ONLY == (k))
    if (ph == 0) { if (EN(7)) phase_prologue(p, shm); continue; }
    const int nin = odd ? CD_IN : AB_IN;
    switch (sub) {
      case 0: if (EN(0)) run_gemm(p.xb, p.wt_in + l * WT_IN_L, nin, DM, pg8::EpiH{p.h, nin, p.sumsq + (2 * l) * NTOK}, shm); break;
      case 1: if (EN(1)) phase_qk(p, l); break;
      case 2: if (odd) { if (EN(2)) phase_attn_odd(p, l, shm); } else { if (EN(8)) phase_attn_even(p, l, shm); } break;
      case 3: if (EN(3)) phase_merge(p); break;
      case 4: if (EN(4)) run_gemm(p.ao, p.wt_out + l * WT_OUT_L, DM, DM, pg8::EpiRes{p.xres, p.xb, p.sumsq + (2 * l + 1) * NTOK}, shm); break;
      case 5: if (EN(5)) run_gemm(p.xb, p.wt_gu + l * WT_GU_L, 2 * FFN, DM, pg8::EpiGU{p.hid, p.sumsq + (2 * l + 1) * NTOK}, shm); break;
      default: if (EN(6)) run_gemm(p.hid, p.wt_dn + l * WT_DN_L, DM, FFN, pg8::EpiRes{p.xres, p.xb, l + 1 < DEPTH ? p.sumsq + (2 * l + 2) * NTOK : nullptr}, shm); break;
    }
  }
}

extern "C" void kernel_launch(void* const* d_in, const int* in_sizes, int n_in, void* d_out, int out_size, void* d_ws, size_t ws_size, hipStream_t stream) {
  Params p; memset(&p, 0, sizeof(p));
  const float** pf = (const float**)&p;
  for (int i = 0; i < 20; ++i) pf[i] = (const float*)d_in[i];
  p.xres = (float*)d_out;
  char* w = (char*)d_ws; size_t off = 0;
  auto take = [&](size_t bytes) { char* r = w + off; off += (bytes + 255) / 256 * 256; return r; };
  p.wt_in = (unsigned short*)take(DEPTH * WT_IN_L * 2); p.wt_out = (unsigned short*)take(DEPTH * WT_OUT_L * 2);
  p.wt_gu = (unsigned short*)take(DEPTH * WT_GU_L * 2); p.wt_dn = (unsigned short*)take(DEPTH * WT_DN_L * 2);
  p.xb = (unsigned short*)take((size_t)NTOK * DM * 2); p.h = (unsigned short*)take((size_t)NTOK * CD_IN * 2);
  p.ao = (unsigned short*)take((size_t)NTOK * DM * 2); p.hid = (unsigned short*)take((size_t)NTOK * FFN * 2);
  p.dpart = (unsigned short*)take((size_t)3 * NTOK * 512 * 2); p.dml = (float*)take((size_t)3 * NTOK * 4 * 2 * 4);
  p.sumsq = (unsigned long long*)take((size_t)8 * NTOK * 8); p.tab_ax = (float*)take(64 * 32 * 2 * 4); p.tab_pr = (float*)take((size_t)SEQ * 16 * 2 * 4);
  static int grid_blocks = 0;
  if (!grid_blocks) {
    if (off > ws_size) { fprintf(stderr, "kernel_launch: ws too small: need %zu have %zu\n", off, ws_size); return; }
    if (hipFuncSetAttribute((const void*)mega, hipFuncAttributeMaxDynamicSharedMemorySize, LDS_BYTES) != hipSuccess) { fprintf(stderr, "kernel_launch: LDS attribute failed\n"); return; }
    int dev = 0, cus = 0, per_cu = 0; hipGetDevice(&dev); hipDeviceGetAttribute(&cus, hipDeviceAttributeMultiprocessorCount, dev);
    hipOccupancyMaxActiveBlocksPerMultiprocessor(&per_cu, mega, 512, LDS_BYTES);
    if (per_cu < 1) { fprintf(stderr, "kernel_launch: occupancy 0\n"); return; }
    grid_blocks = cus;
  }
#ifdef MK_MULTI
  for (int ph = 0; ph < NPHASE; ++ph) { const int l = (ph - 1) / 7, sub = (ph - 1) % 7; if (ph > 0 && sub == 3 && !(l & 1)) continue;
    hipLaunchKernelGGL(mega, dim3(grid_blocks), dim3(512), LDS_BYTES, stream, p, ph, ph + 1); }
#else
  int ph0 = 0, ph1 = NPHASE; void* args[] = {&p, &ph0, &ph1};
  hipError_t e = hipLaunchCooperativeKernel((const void*)mega, dim3(grid_blocks), dim3(512), args, LDS_BYTES, stream);
  if (e != hipSuccess) fprintf(stderr, "cooperative launch failed: %s (grid %d)\n", hipGetErrorString(e), grid_blocks);
#endif
}
```

```cpp
#include <hip/hip_runtime.h>
#include <hip/hip_bf16.h>
#include <hip/hip_cooperative_groups.h>
#include <cstdio>
#include <cstring>
#include <cstdint>
namespace cg = cooperative_groups;
__device__ __forceinline__ int otid() { int t = threadIdx.x; asm volatile("" : "+v"(t)); return t; }
__device__ __forceinline__ int obid() { int t = blockIdx.x; asm volatile("" : "+s"(t)); return t; }
__device__ __forceinline__ int ogdim() { int t = gridDim.x; asm volatile("" : "+s"(t)); return t; }

constexpr int DM = 2048, SEQ = 4096, NTOK = 8192, DEPTH = 4;
constexpr int AB_IN = 4608, CD_IN = 5120, FFN = 5632;
constexpr float EPS = 1e-6f;


constexpr size_t WT_IN_L = (size_t)CD_IN * DM, WT_OUT_L = (size_t)DM * DM, WT_GU_L = (size_t)2 * FFN * DM, WT_DN_L = (size_t)DM * FFN;
constexpr size_t al256(size_t x) { return (x + 255) / 256 * 256; }
constexpr size_t O_WT_IN = 0, O_WT_OUT = O_WT_IN + al256(DEPTH * WT_IN_L * 2), O_WT_GU = O_WT_OUT + al256(DEPTH * WT_OUT_L * 2), O_WT_DN = O_WT_GU + al256(DEPTH * WT_GU_L * 2),
  O_XB = O_WT_DN + al256(DEPTH * WT_DN_L * 2), O_H = O_XB + al256((size_t)NTOK * DM * 2), O_AO = O_H + al256((size_t)NTOK * CD_IN * 2), O_HID = O_AO + al256((size_t)NTOK * DM * 2),
  O_DPART = O_HID + al256((size_t)NTOK * FFN * 2), O_DML = O_DPART + al256((size_t)3 * NTOK * 512 * 2), O_SUMSQ = O_DML + al256((size_t)3 * NTOK * 4 * 2 * 4), O_TAB_AX = O_SUMSQ + al256((size_t)8 * NTOK * 8),
  O_TAB_PR = O_TAB_AX + al256(64 * 32 * 2 * 4), O_BAR = O_TAB_PR + al256((size_t)SEQ * 16 * 2 * 4), WS_END = O_BAR + al256(4096 * 4);
__device__ const float kInvRevAxF[32] = {0.15915494309189535f, 0.11934937021124886f, 0.089499401608891013f, 0.067115083005227255f, 0.050329212104487035f, 0.037741584717419771f, 0.028302195830623399f, 0.02122365276477766f, 0.015915494309189534f, 0.011934937021124886f, 0.0089499401608891024f, 0.0067115083005227253f, 0.0050329212104487037f, 0.0037741584717419772f, 0.0028302195830623399f, 0.0021223652764777662f, 0.0015915494309189536f, 0.0011934937021124885f, 0.00089499401608891024f, 0.0006711508300522726f, 0.00050329212104487033f, 0.00037741584717419774f, 0.00028302195830623395f, 0.00021223652764777661f, 0.00015915494309189535f, 0.00011934937021124886f, 8.9499401608891018e-05f, 6.7115083005227254e-05f, 5.0329212104487035e-05f, 3.7741584717419777e-05f, 2.8302195830623396e-05f, 2.1223652764777659e-05f};
__device__ const float kInvRevPrF[16] = {0.15915494309189535f, 0.070086521587798503f, 0.03086376340470123f, 0.013591370636193905f, 0.0059851857127137054f, 0.002635675898667414f, 0.001160663641240061f, 0.00051111750453754386f, 0.00022507907903927653f, 9.9117309369019355e-05f, 4.3647952792802891e-05f, 1.9221100684944863e-05f, 8.4643308082414014e-06f, 3.7274086019153519e-06f, 1.6414262627950345e-06f, 7.2282930688328648e-07f};
struct Params {
  const float *x, *attn_norm, *ffn_norm, *ab_w_in, *ab_w_out, *a_qn, *a_kn, *a_rpb, *b_qn, *b_kn,
              *cd_w_in, *cd_w_out, *c_qn, *c_kn, *c_sink, *d_qn, *d_kn, *w_gate, *w_up, *w_down;
  float* xres;
  char* ws;
  __device__ __forceinline__ unsigned short* wt_in() const { return (unsigned short*)(ws + O_WT_IN); }
  __device__ __forceinline__ unsigned short* wt_out() const { return (unsigned short*)(ws + O_WT_OUT); }
  __device__ __forceinline__ unsigned short* wt_gu() const { return (unsigned short*)(ws + O_WT_GU); }
  __device__ __forceinline__ unsigned short* wt_dn() const { return (unsigned short*)(ws + O_WT_DN); }
  __device__ __forceinline__ unsigned short* xb() const { return (unsigned short*)(ws + O_XB); }
  __device__ __forceinline__ unsigned short* h() const { return (unsigned short*)(ws + O_H); }
  __device__ __forceinline__ unsigned short* ao() const { return (unsigned short*)(ws + O_AO); }
  __device__ __forceinline__ unsigned short* hid() const { return (unsigned short*)(ws + O_HID); }
  __device__ __forceinline__ unsigned short* dpart() const { return (unsigned short*)(ws + O_DPART); }
  __device__ __forceinline__ float* dml() const { return (float*)(ws + O_DML); }
  __device__ __forceinline__ unsigned long long* sumsq() const { return (unsigned long long*)(ws + O_SUMSQ); }
  __device__ __forceinline__ unsigned* bar() const { return (unsigned*)(ws + O_BAR); }
};

namespace pg8 {
#define PG8_LAS __attribute__((address_space(3)))
typedef unsigned short bf16_t;
typedef short bf16x8 __attribute__((ext_vector_type(8)));
typedef float f32x4 __attribute__((ext_vector_type(4)));
typedef unsigned u32x4 __attribute__((ext_vector_type(4)));
constexpr int BM = 256, BK = 64, HALF = 128, HTB = HALF * BK * 2  , STAGE_BYTES = 8 * HTB, NXCD = 8, WGM = 8;

__host__ __device__ __forceinline__ int lds_byte(int r, int c) { const int st = (r >> 4) * 2 + (c >> 5), rr = r & 15, cc = c & 31, ob = rr * 64 + cc * 2; return st * 1024 + (ob ^ (((ob >> 9) & 1) << 5)); }
__host__ __device__ __forceinline__ void stage_rc(int b, int& R, int& C) { const int st = b / 1024, sb = b % 1024, swz = sb ^ (((sb >> 9) & 1) << 5); R = (st >> 1) * 16 + swz / 64; C = (st & 1) * 32 + (swz % 64) / 2; }
__host__ __device__ __forceinline__ int perm32(int rho) { const int n = rho >> 4, i = rho & 15; return 8 * (i >> 2) + 4 * n + (i & 3); }

struct Unit { int pm, pn; };
struct Gemm { const bf16_t* A; const bf16_t* Bt; int M, N, K; };

struct StaticOrder {
    int nM, nN, nwg, G, c;
    __host__ __device__ void init(int M, int N, int G_, int c_) { nM = M / BM; nN = N / BM; nwg = nM * nN; G = G_; c = c_; }
    __host__ __device__ bool next(int i, Unit& u) const {
        const long L = (long)i * G + c; if (L >= nwg) return false;
        int wgid = (int)L; { const int q = nwg / NXCD, r = nwg % NXCD, xcd = wgid % NXCD, off = wgid / NXCD; wgid = (xcd < r ? xcd * (q + 1) : r * (q + 1) + (xcd - r) * q) + off; }
        const int nig = WGM * nN, gid = wgid / nig, fm = gid * WGM, gsz = (nM - fm) < WGM ? (nM - fm) : WGM;
        u.pm = fm + ((wgid % nig) % gsz); u.pn = (wgid % nig) / gsz; return true;
    }
    __device__ __forceinline__ void a_ready(const Unit&) const {}
    __device__ __forceinline__ void done(const Unit&) const {}
};

__device__ __forceinline__ unsigned cvt_pk_bf16(float lo, float hi) { unsigned r; asm volatile("v_cvt_pk_bf16_f32 %0, %1, %2" : "=v"(r) : "v"(lo), "v"(hi)); return r; }

__device__ __forceinline__ u32x4 lane_t416(u32x4 w, int srcb) {
    u32x4 r; r[0] = (unsigned)__builtin_amdgcn_ds_bpermute(srcb, (int)w[0]); r[1] = (unsigned)__builtin_amdgcn_ds_bpermute(srcb, (int)w[1]);
    r[2] = (unsigned)__builtin_amdgcn_ds_bpermute(srcb, (int)w[2]); r[3] = (unsigned)__builtin_amdgcn_ds_bpermute(srcb, (int)w[3]); return r;
}
struct EpiHN {
    static constexpr bool PERM = true, AFTER_DRAIN = false;
    bf16_t* O; int ldc; const unsigned long long* ss; const float *qn0, *kn0, *qn1, *kn1; int odd; PG8_LAS float* red;
    __device__ __forceinline__ void operator()(const f32x4 (&acc)[2][2][4][2], const Unit& u, int, int, int, int) const {
        const int t_ = otid(), wid_ = t_ >> 6, wr = wid_ >> 2, wc = wid_ & 3, fr = t_ & 15, fq = (t_ >> 4) & 3, ln = t_ & 63, fr2 = ln >> 2, fq2 = ln & 3;
        const int srcb = 4 * ((ln & 3) * 16 + (ln >> 2));
        const int row0 = u.pm * BM + wr * 64, head0 = 2 * u.pn;
        const float* gw; int rope;
        if (!odd) { rope = 0; if (head0 < 8) gw = qn0; else if (head0 < 16) gw = kn0; else if (head0 < 24) gw = nullptr; else if (head0 < 32) { gw = qn1; rope = 1; } else if (head0 < 34) { gw = kn1; rope = 1; } else gw = nullptr; }
        else { rope = 2; if (head0 < 12) gw = qn0; else if (head0 < 16) gw = kn0; else if (head0 < 20) gw = nullptr; else if (head0 < 32) gw = qn1; else if (head0 < 36) gw = kn1; else gw = nullptr; }
        unsigned long long sv[2][4];
#pragma unroll
        for (int ai = 0; ai < 2; ++ai)
#pragma unroll
            for (int m = 0; m < 4; ++m) sv[ai][m] = ss[row0 + fr + ai * HALF + m * 16];
        float rs[2][4];
#pragma unroll
        for (int ai = 0; ai < 2; ++ai)
#pragma unroll
            for (int m = 0; m < 4; ++m) rs[ai][m] = __builtin_amdgcn_rsqf((float)sv[ai][m] * (1.0f / (2048.0f * 16777216.0f)) + 1e-6f);
        if (gw == nullptr) {
#pragma unroll
            for (int ai = 0; ai < 2; ++ai)
#pragma unroll
                for (int m = 0; m < 4; ++m) { bf16_t* rowp = O + (size_t)(row0 + fr2 + ai * HALF + m * 16) * ldc + u.pn * BM + wc * 32 + 8 * fq2;
#pragma unroll
                    for (int bj = 0; bj < 2; ++bj) { const f32x4 v0 = acc[ai][bj][m][0] * rs[ai][m], v1 = acc[ai][bj][m][1] * rs[ai][m];
                        u32x4 w = {cvt_pk_bf16(v0[0], v0[1]), cvt_pk_bf16(v0[2], v0[3]), cvt_pk_bf16(v1[0], v1[1]), cvt_pk_bf16(v1[2], v1[3])};
                        *(u32x4*)(rowp + bj * HALF) = lane_t416(w, srcb); } }
            return;
        }
        const int c8 = wc * 32 + fq * 8;
        float gwv[8], fqv[4];
#pragma unroll
        for (int e = 0; e < 8; ++e) { const int s_ = c8 + e, t = s_ >> 1;
            const int dim = rope == 1 ? ((t < 32 ? t : t + 32) + 32 * (s_ & 1)) : (rope == 2 && s_ < 32) ? (t + 16 * (s_ & 1)) : s_;
            gwv[e] = gw[dim]; }
        const bool dorope = (rope == 1) || (rope == 2 && wc == 0);
#pragma unroll
        for (int k = 0; k < 4; ++k) { const int t = (c8 >> 1) + k; fqv[k] = rope == 1 ? kInvRevAxF[t & 31] : kInvRevPrF[t & 15]; }
#pragma unroll
        for (int ai = 0; ai < 2; ++ai)
#pragma unroll
            for (int m = 0; m < 4; ++m)
#pragma unroll
                for (int bj = 0; bj < 2; ++bj) { float p = 0.f;
#pragma unroll
                    for (int n = 0; n < 2; ++n)
#pragma unroll
                        for (int j = 0; j < 4; ++j) { const float v = acc[ai][bj][m][n][j] * rs[ai][m]; p += v * v; }
                    p += __shfl_xor(p, 16); p += __shfl_xor(p, 32);
                    if (fq == 0) red[((wr * 128 + (ai * 4 + m) * 16 + fr) * 2 + bj) * 4 + wc] = p; }
        asm volatile("s_waitcnt lgkmcnt(0)" ::: "memory"); __builtin_amdgcn_s_barrier(); asm volatile("" ::: "memory");
#pragma unroll
        for (int ai = 0; ai < 2; ++ai)
#pragma unroll
            for (int m = 0; m < 4; ++m) { const int pos = (row0 + fr + ai * HALF + m * 16) & 4095; float cs[4], sn[4];
                if (dorope) { const float P = rope == 1 ? (float)(wc < 2 ? (pos >> 6) : (pos & 63)) : (float)pos;
#pragma unroll
                    for (int k = 0; k < 4; ++k) { const float x = __builtin_amdgcn_fractf(P * fqv[k]); cs[k] = __builtin_amdgcn_cosf(x); sn[k] = __builtin_amdgcn_sinf(x); } }
                bf16_t* rowp = O + (size_t)(row0 + fr2 + ai * HALF + m * 16) * ldc + u.pn * BM + wc * 32 + 8 * fq2;
#pragma unroll
                for (int bj = 0; bj < 2; ++bj) { const f32x4 r4 = *(const PG8_LAS f32x4*)(red + ((wr * 128 + (ai * 4 + m) * 16 + fr) * 2 + bj) * 4);
                    const float rsh = __builtin_amdgcn_rsqf((r4[0] + r4[1] + r4[2] + r4[3]) * (1.0f / 128.0f) + 1e-6f) * rs[ai][m];
                    float y[8];
#pragma unroll
                    for (int n = 0; n < 2; ++n)
#pragma unroll
                        for (int j = 0; j < 4; ++j) y[n * 4 + j] = acc[ai][bj][m][n][j] * rsh * gwv[n * 4 + j];
                    if (dorope) {
#pragma unroll
                        for (int k = 0; k < 4; ++k) { const float x1 = y[2 * k], x2 = y[2 * k + 1]; y[2 * k] = x1 * cs[k] - x2 * sn[k]; y[2 * k + 1] = x1 * sn[k] + x2 * cs[k]; } }
                    u32x4 w = {cvt_pk_bf16(y[0], y[1]), cvt_pk_bf16(y[2], y[3]), cvt_pk_bf16(y[4], y[5]), cvt_pk_bf16(y[6], y[7])};
                    *(u32x4*)(rowp + bj * HALF) = lane_t416(w, srcb); } }
    }
};
struct EpiGU {
    static constexpr bool PERM = true, AFTER_DRAIN = false;
    bf16_t* O; const unsigned long long* ss;
    __device__ __forceinline__ void operator()(const f32x4 (&acc)[2][2][4][2], const Unit& u, int, int, int, int) const {
        const int t_ = otid(), wid_ = t_ >> 6, wr = wid_ >> 2, wc = wid_ & 3, fr = t_ & 15, ln = t_ & 63, fr2 = ln >> 2, fq2 = ln & 3;
        const int srcb = 4 * ((ln & 3) * 16 + (ln >> 2));
        const int row0 = u.pm * BM + wr * 64, col0 = u.pn * HALF + wc * 32 + 8 * fq2;
        unsigned long long sv[2][4];
#pragma unroll
        for (int ai = 0; ai < 2; ++ai)
#pragma unroll
            for (int m = 0; m < 4; ++m) sv[ai][m] = ss[row0 + fr + ai * HALF + m * 16];
#pragma unroll
        for (int ai = 0; ai < 2; ++ai)
#pragma unroll
            for (int m = 0; m < 4; ++m) { const float rs = __builtin_amdgcn_rsqf((float)sv[ai][m] * (1.0f / (2048.0f * 16777216.0f)) + 1e-6f);
                float o[8];
#pragma unroll
                for (int n = 0; n < 2; ++n)
#pragma unroll
                    for (int j = 0; j < 4; ++j) { const float g = acc[ai][0][m][n][j] * rs, up = acc[ai][1][m][n][j] * rs;
                        const float sg = g * __builtin_amdgcn_rcpf(1.0f + __builtin_amdgcn_exp2f(-1.4426950408889634f * g)); o[n * 4 + j] = sg * up; }
                u32x4 w = {cvt_pk_bf16(o[0], o[1]), cvt_pk_bf16(o[2], o[3]), cvt_pk_bf16(o[4], o[5]), cvt_pk_bf16(o[6], o[7])};
                *(u32x4*)(O + (size_t)(row0 + fr2 + ai * HALF + m * 16) * 5632 + col0) = lane_t416(w, srcb); }
    }
};
template <bool FINAL> struct EpiResT {
    static constexpr bool PERM = true, AFTER_DRAIN = false;
    float* Xout; bf16_t* XB; unsigned long long* ssn;
    __device__ __forceinline__ void operator()(const f32x4 (&acc)[2][2][4][2], const Unit& u, int, int, int, int) const {
        const int t_ = otid(), wid_ = t_ >> 6, wr = wid_ >> 2, wc = wid_ & 3, fr = t_ & 15, fq = (t_ >> 4) & 3, ln = t_ & 63, fr2 = ln >> 2, fq2 = ln & 3;
        const int srcb = 4 * ((ln & 3) * 16 + (ln >> 2));
        const int row0 = u.pm * BM + wr * 64 + fr, col0 = u.pn * BM + wc * 32 + 8 * fq;
        u32x4 xo[4][2], xn[4][2];
#define ER_LOAD(dst, ai) do { _Pragma("unroll") for (int m = 0; m < 4; ++m) { const bf16_t* br = XB + (size_t)(row0 + (ai) * HALF + m * 16) * 2048 + col0; \
            _Pragma("unroll") for (int bj = 0; bj < 2; ++bj) dst[m][bj] = *(const u32x4*)(br + bj * HALF); } } while (0)
        ER_LOAD(xo, 0);
#pragma unroll
        for (int ai = 0; ai < 2; ++ai) {
            if (ai == 0) ER_LOAD(xn, 1);
#pragma unroll
            for (int m = 0; m < 4; ++m) { const int row = row0 + ai * HALF + m * 16; float part = 0.f; bf16_t* br = XB + (size_t)row * 2048 + col0;
#pragma unroll
                for (int bj = 0; bj < 2; ++bj) { const u32x4 o = xo[m][bj];
                    f32x4 a = {__uint_as_float(o[0] << 16), __uint_as_float(o[0] & 0xffff0000u), __uint_as_float(o[1] << 16), __uint_as_float(o[1] & 0xffff0000u)};
                    f32x4 b = {__uint_as_float(o[2] << 16), __uint_as_float(o[2] & 0xffff0000u), __uint_as_float(o[3] << 16), __uint_as_float(o[3] & 0xffff0000u)};
                    a += acc[ai][bj][m][0]; b += acc[ai][bj][m][1];
                    if constexpr (FINAL) { float* xr = Xout + (size_t)row * 2048 + col0 + bj * HALF; *(f32x4*)xr = a; *(f32x4*)(xr + 4) = b; }
                    else { u32x4 w = {cvt_pk_bf16(a[0], a[1]), cvt_pk_bf16(a[2], a[3]), cvt_pk_bf16(b[0], b[1]), cvt_pk_bf16(b[2], b[3])};
                        *(u32x4*)(XB + (size_t)(row - fr + fr2) * 2048 + col0 - 8 * fq + 8 * fq2 + bj * HALF) = lane_t416(w, srcb);
                        part += a[0] * a[0] + a[1] * a[1] + a[2] * a[2] + a[3] * a[3] + b[0] * b[0] + b[1] * b[1] + b[2] * b[2] + b[3] * b[3]; } }
                if constexpr (!FINAL) { part += __shfl_xor(part, 16); part += __shfl_xor(part, 32);
                    if (fq == 0) atomicAdd(ssn + row, (unsigned long long)(part * 16777216.0f)); } }
            if (ai == 0) {
#pragma unroll
                for (int m = 0; m < 4; ++m)
#pragma unroll
                    for (int bj = 0; bj < 2; ++bj) xo[m][bj] = xn[m][bj]; }
        }
#undef ER_LOAD
    }
};
template <class Epi, class Sched, bool STAMP = false>
__device__ __forceinline__ void gemm_phase(PG8_LAS unsigned char* lds, const Gemm g, const Sched& S, const Epi& E, unsigned long long* stamps) {
    const int tid = otid(), wid = __builtin_amdgcn_readfirstlane(tid >> 6), lane = tid & 63, wr = wid >> 2, wc = wid & 3, fr = lane & 15, fq = lane >> 4;
    const int K = g.K, nt = K / BK;
    int ts_lo = 0, ts_hi = 0, nts = 0; const unsigned long long rt_entry = STAMP ? (unsigned long long)wall_clock64() : 0ull;
#define PG8_STAMP() do { if (STAMP && wid == 0 && nts < 64) { const unsigned long long _c = (unsigned long long)clock64(); \
        ts_lo = (lane == nts) ? (int)(unsigned)_c : ts_lo; ts_hi = (lane == nts) ? (int)(unsigned)(_c >> 32) : ts_hi; ++nts; } } while (0)
    PG8_STAMP();
    unsigned voffA[2], voffB[2];
#pragma unroll
    for (int i = 0; i < 2; ++i) { int R, C; stage_rc(tid * 16 + i * 8192, R, C); const int Rb = Epi::PERM ? ((R & ~31) + perm32(R & 31)) : R;
        voffA[i] = (unsigned)(R * K + C) * 2u; voffB[i] = (unsigned)(Rb * K + C) * 2u; }
    const size_t kstep = (size_t)(BK * 2);
    const size_t hstep = (size_t)HALF * K * 2;
    const size_t tstep = 2 * hstep;
    const unsigned ldsw = (unsigned)wid * 1024u;
    const int aoff = lds_byte(wr * 64 + fr, fq * 8), boff = lds_byte(wc * 32 + fr, fq * 8);
#define PG8_SA(b, h) (((b) * 2 + (h)) * HTB)
#define PG8_SB(b, h) ((4 + (b) * 2 + (h)) * HTB)
#define PG8_STAGE(bufoff, gbase, voff) do { _Pragma("unroll") for (int _i = 0; _i < 2; ++_i) \
        __builtin_amdgcn_global_load_lds((const unsigned*)((const char*)(gbase) + (voff)[_i]), (PG8_LAS unsigned*)(lds + (bufoff) + ldsw + _i * 8192), 16, 0, 0); } while (0)
#define PG8_LDA(dst, b, h) do { _Pragma("unroll") for (int m = 0; m < 4; ++m) _Pragma("unroll") for (int k = 0; k < 2; ++k) dst[m][k] = *(const PG8_LAS bf16x8*)(lds + PG8_SA(b, h) + aoff + m * 2048 + k * 1024); } while (0)
#define PG8_LDB(dst, b, h) do { _Pragma("unroll") for (int n = 0; n < 2; ++n) _Pragma("unroll") for (int k = 0; k < 2; ++k) dst[n][k] = *(const PG8_LAS bf16x8*)(lds + PG8_SB(b, h) + boff + n * 2048 + k * 1024); } while (0)
#define PG8_MMA(ai, bj, At, Bt) do { __builtin_amdgcn_s_setprio(1); _Pragma("unroll") for (int m = 0; m < 4; ++m) _Pragma("unroll") for (int n = 0; n < 2; ++n) _Pragma("unroll") for (int k = 0; k < 2; ++k) \
        acc[ai][bj][m][n] = __builtin_amdgcn_mfma_f32_16x16x32_bf16(Bt[n][k], At[m][k], acc[ai][bj][m][n], 0, 0, 0); __builtin_amdgcn_s_setprio(0); } while (0)
#define PG8_WAIT_V(n) asm volatile("s_waitcnt vmcnt(" #n ")" ::: "memory")
#define PG8_WAIT_L(n) asm volatile("s_waitcnt lgkmcnt(" #n ")" ::: "memory")
#define PG8_BAR __builtin_amdgcn_s_barrier()
#define PG8_SCHED __builtin_amdgcn_sched_barrier(0)
    Unit cur, nxt; int ui = 0;
    if (!S.next(0, cur)) return;
    f32x4 acc[2][2][4][2];
#pragma unroll
    for (int a = 0; a < 2; ++a)
#pragma unroll
        for (int b = 0; b < 2; ++b)
#pragma unroll
            for (int m = 0; m < 4; ++m)
#pragma unroll
                for (int n = 0; n < 2; ++n) acc[a][b][m][n] = (f32x4){0.f, 0.f, 0.f, 0.f};
    bf16x8 At[4][2], B0[2][2], B1[2][2];
    const char* cA = (const char*)g.A + (size_t)cur.pm * tstep; const char* cB = (const char*)g.Bt + (size_t)cur.pn * tstep;
    S.a_ready(cur);
    PG8_STAGE(PG8_SB(0, 0), cB, voffB); PG8_STAGE(PG8_SA(0, 0), cA, voffA); PG8_STAGE(PG8_SB(0, 1), cB + hstep, voffB); PG8_STAGE(PG8_SA(0, 1), cA + hstep, voffA);
    if (wr == 1) PG8_BAR;
    PG8_WAIT_V(4); PG8_BAR;
    PG8_STAGE(PG8_SB(1, 0), cB + kstep, voffB); PG8_STAGE(PG8_SA(1, 0), cA + kstep, voffA); PG8_STAGE(PG8_SB(1, 1), cB + hstep + kstep, voffB);
    PG8_WAIT_V(6); PG8_BAR;
    PG8_STAMP();
    for (;;) {
        const bool has_next = S.next(ui + 1, nxt);
        const char* nA = has_next ? (const char*)g.A + (size_t)nxt.pm * tstep : cA; const char* nB = has_next ? (const char*)g.Bt + (size_t)nxt.pn * tstep : cB;
        for (int t = 0; t < nt; t += 2) {
            const bool last = (t == nt - 2);
            const char* a1 = cA + (size_t)(t + 1) * kstep;
            const char* a2 = last ? nA : cA + (size_t)(t + 2) * kstep; const char* b2 = last ? nB : cB + (size_t)(t + 2) * kstep;
            const char* a3 = a2 + kstep; const char* b3 = b2 + kstep;
            if (last && has_next) S.a_ready(nxt);
            PG8_LDB(B0, 0, 0); PG8_SCHED; PG8_LDA(At, 0, 0); PG8_STAGE(PG8_SA(1, 1), a1 + hstep, voffA);
            PG8_WAIT_L(8); PG8_BAR; PG8_WAIT_L(0); PG8_MMA(0, 0, At, B0); PG8_BAR; PG8_SCHED;
            PG8_LDB(B1, 0, 1); PG8_STAGE(PG8_SB(0, 0), b2, voffB);
            PG8_BAR; PG8_WAIT_L(0); PG8_MMA(0, 1, At, B1); PG8_BAR;
            PG8_LDA(At, 0, 1); PG8_STAGE(PG8_SA(0, 0), a2, voffA);
            PG8_BAR; PG8_WAIT_L(0); PG8_MMA(1, 0, At, B0); PG8_BAR; PG8_SCHED;
            PG8_STAGE(PG8_SB(0, 1), b2 + hstep, voffB);
            PG8_WAIT_V(6); PG8_BAR; PG8_MMA(1, 1, At, B1); PG8_BAR;
            PG8_LDB(B0, 1, 0); PG8_SCHED; PG8_LDA(At, 1, 0); PG8_STAGE(PG8_SA(0, 1), a2 + hstep, voffA);
            PG8_WAIT_L(8); PG8_BAR; PG8_WAIT_L(0); PG8_MMA(0, 0, At, B0); PG8_BAR; PG8_SCHED;
            PG8_LDB(B1, 1, 1); PG8_STAGE(PG8_SB(1, 0), b3, voffB);
            PG8_BAR; PG8_WAIT_L(0); PG8_MMA(0, 1, At, B1); PG8_BAR;
            PG8_LDA(At, 1, 1); PG8_STAGE(PG8_SA(1, 0), a3, voffA);
            PG8_BAR; PG8_WAIT_L(0); PG8_MMA(1, 0, At, B0); PG8_BAR; PG8_SCHED;
            PG8_STAGE(PG8_SB(1, 1), b3 + hstep, voffB);
            PG8_WAIT_V(6); PG8_BAR; PG8_MMA(1, 1, At, B1); PG8_BAR;
        }
        PG8_STAMP();
        if constexpr (!Epi::AFTER_DRAIN) { E(acc, cur, wr, wc, fr, fq); S.done(cur); }
        PG8_STAMP();
        if (!has_next) break;
#pragma unroll
        for (int a = 0; a < 2; ++a)
#pragma unroll
            for (int b = 0; b < 2; ++b)
#pragma unroll
                for (int m = 0; m < 4; ++m)
#pragma unroll
                    for (int n = 0; n < 2; ++n) acc[a][b][m][n] = (f32x4){0.f, 0.f, 0.f, 0.f};
        cur = nxt; cA = nA; cB = nB; ++ui;
    }
    PG8_WAIT_V(0);
    if (wr == 0) PG8_BAR;
    PG8_BAR;
    if constexpr (Epi::AFTER_DRAIN) { E.fused(acc, cur, wr, wc, fr, fq, lds, wid, lane); S.done(cur); }
    PG8_STAMP();
    if (STAMP && wid == 0) { stamps[lane] = lane < nts ? (((unsigned long long)(unsigned)ts_hi << 32) | (unsigned)ts_lo) : 0ull;
        if (lane == 62) stamps[62] = rt_entry; if (lane == 63) stamps[63] = (unsigned long long)wall_clock64(); }
#undef PG8_STAMP
#undef PG8_SA
#undef PG8_SB
#undef PG8_STAGE
#undef PG8_LDA
#undef PG8_LDB
#undef PG8_MMA
#undef PG8_WAIT_V
#undef PG8_WAIT_L
#undef PG8_BAR
#undef PG8_SCHED
}
}

namespace at {
using bf16 = __hip_bfloat16;
constexpr int D = 128, NW = 8, QBLK = 32, KVBLK = 64;
constexpr float SCALE = 0.088388347648318440f;
constexpr float THR = 8.f;
constexpr size_t SHM_V = KVBLK * D * 2, SHM_K = KVBLK * D * 2, SHM_ATTN = 2 * SHM_V + 2 * SHM_K + NW * 64 * 4;
using bf16x8 = __attribute__((ext_vector_type(8))) short;
using s16x4  = __attribute__((ext_vector_type(4))) short;
using f32x16 = __attribute__((ext_vector_type(16))) float;
using u32x4  = __attribute__((ext_vector_type(4))) unsigned;
#define KSWZ(row, colB) ((row) * 256 + ((colB) ^ (((row) & 7) << 4)))
#define SBAR() __builtin_amdgcn_sched_barrier(0)
__device__ __forceinline__ int crow(int r, int hi) { return (r & 3) + 8 * (r >> 2) + 4 * hi; }
__device__ __forceinline__ unsigned cvtpk(float lo, float hi) {
  unsigned r; asm volatile("v_cvt_pk_bf16_f32 %0, %1, %2" : "=v"(r) : "v"(lo), "v"(hi)); return r;
}
struct PolNone { __device__ __forceinline__ void apply(f32x16&, f32x16&, int, int) const {} __device__ __forceinline__ bool live(int) const { return true; } };
struct PolWin {
  int qp, kb0, W, qw0;
  __device__ __forceinline__ bool live(int t) const { const int k0 = kb0 + 64 * t; return __builtin_amdgcn_readfirstlane((k0 <= qw0 + 31 + W) && (k0 + 63 >= qw0 - W)) != 0; }
  __device__ __forceinline__ void apply(f32x16& p0, f32x16& p1, int t, int hi) const {
    const int base = kb0 + 64 * t - qp + 4 * hi + W; const unsigned lim = 2u * (unsigned)W;
#pragma unroll
    for (int r = 0; r < 16; ++r) { const int d0 = base + (r & 3) + 8 * (r >> 2);
      p0[r] = ((unsigned)d0 > lim) ? -INFINITY : p0[r]; p1[r] = ((unsigned)(d0 + 32) > lim) ? -INFINITY : p1[r]; }
  }
};
struct PolNA {
  int r, c, rstart; const float* rpb;
  __device__ __forceinline__ bool live(int t) const { const int rho = rstart + t, r0 = min(max(r - 4, 0), 56); return __builtin_amdgcn_readfirstlane((rho >= r0) && (rho < r0 + 8)) != 0; }
  __device__ __forceinline__ void apply(f32x16& p0, f32x16& p1, int t, int hi) const {
    const int rho = rstart + t; const int r0 = min(max(r - 4, 0), 56), c0 = min(max(c - 8, 0), 48);
    const bool rv = (rho >= r0) && (rho < r0 + 8);
    const int bbase = rv ? (rho - r + 7) * 31 + 15 - c : 15 - c;
    constexpr float ISC = 11.313708498984761f;
#pragma unroll
    for (int rr = 0; rr < 16; ++rr) { const int k0 = (rr & 3) + 8 * (rr >> 2) + 4 * hi, k1 = k0 + 32;
      const bool v0 = rv && ((unsigned)(k0 - c0) < 16u), v1 = rv && ((unsigned)(k1 - c0) < 16u);
      const float b0 = rpb[v0 ? bbase + k0 : 0], b1 = rpb[v1 ? bbase + k1 : 0];
      p0[rr] = v0 ? fmaf(b0, ISC, p0[rr]) : -INFINITY; p1[rr] = v1 ? fmaf(b1, ISC, p1[rr]) : -INFINITY; }
  }
};
template <class Pol>
__device__ __forceinline__ void partialSM(f32x16& p0, f32x16& p1, float& m_reg, float& mn, float& alpha, const Pol& pol, int tile, int hi) {
  constexpr float C = SCALE * 1.4426950408889634f;
  pol.apply(p0, p1, tile, hi);
  float pmax = p0[0];
#pragma unroll
  for (int r = 1; r < 16; ++r) pmax = fmaxf(pmax, p0[r]);
#pragma unroll
  for (int r = 0; r < 16; ++r) pmax = fmaxf(pmax, p1[r]);
  { auto rr = __builtin_amdgcn_permlane32_swap(__float_as_uint(pmax), __float_as_uint(pmax), false, false);
    pmax = fmaxf(__uint_as_float(rr[0]), __uint_as_float(rr[1])); }
  if (__builtin_expect(__all(pmax - m_reg <= THR / SCALE), 1)) { mn = m_reg; alpha = 1.f; }
  else { mn = fmaxf(m_reg, pmax); alpha = __builtin_amdgcn_exp2f((m_reg - mn) * C); m_reg = mn; }
  float mnC = -mn * C;
#pragma unroll
  for (int r = 0; r < 16; ++r) p0[r] = fmaf(p0[r], C, mnC);
#pragma unroll
  for (int r = 0; r < 16; ++r) p1[r] = fmaf(p1[r], C, mnC);
#pragma unroll
  for (int r = 0; r < 16; ++r) p0[r] = __builtin_amdgcn_exp2f(p0[r]);
}
__device__ __forceinline__ void finishSM(f32x16& p0, f32x16& p1, float alpha, float& l_reg, bf16x8& pa0, bf16x8& pa1, bf16x8& pa2, bf16x8& pa3) {
#pragma unroll
  for (int r = 0; r < 16; ++r) p1[r] = __builtin_amdgcn_exp2f(p1[r]);
  float ps = 0;
#pragma unroll
  for (int r = 0; r < 16; ++r) ps += p0[r];
#pragma unroll
  for (int r = 0; r < 16; ++r) ps += p1[r];
  { auto rr = __builtin_amdgcn_permlane32_swap(__float_as_uint(ps), __float_as_uint(ps), false, false);
    ps = __uint_as_float(rr[0]) + __uint_as_float(rr[1]); }
  l_reg = l_reg * alpha + ps;
#define PK4(P, BASE, OUT) do { unsigned a0 = cvtpk(P[BASE + 0], P[BASE + 1]), a1 = cvtpk(P[BASE + 2], P[BASE + 3]);   \
    unsigned b0 = cvtpk(P[BASE + 4], P[BASE + 5]), b1 = cvtpk(P[BASE + 6], P[BASE + 7]);                              \
    auto r0 = __builtin_amdgcn_permlane32_swap(a0, b0, false, false); auto r1 = __builtin_amdgcn_permlane32_swap(a1, b1, false, false); \
    u32x4 w = {r0[0], r1[0], r0[1], r1[1]}; OUT = *reinterpret_cast<bf16x8*>(&w); } while (0)
  PK4(p0, 0, pa0); PK4(p0, 8, pa1); PK4(p1, 0, pa2); PK4(p1, 8, pa3);
#undef PK4
}
__device__ __forceinline__ void qkt(f32x16& p0, f32x16& p1, const bf16* Ks, const bf16x8* qr, int r32, int hi) {
  p0 = f32x16{}; p1 = f32x16{};
#pragma unroll
  for (int d0 = 0; d0 < 8; ++d0) { int cb = (d0 * 16 + hi * 8) * 2;
    bf16x8 b0 = *reinterpret_cast<const bf16x8*>((const char*)Ks + KSWZ(r32, cb));
    bf16x8 b1 = *reinterpret_cast<const bf16x8*>((const char*)Ks + KSWZ(32 + r32, cb));
    p0 = __builtin_amdgcn_mfma_f32_32x32x16_bf16(b0, qr[d0], p0, 0, 0, 0);
    p1 = __builtin_amdgcn_mfma_f32_32x32x16_bf16(b1, qr[d0], p1, 0, 0, 0); }
}
__device__ __forceinline__ int v_st(int k, int c) { const int kk = (k & ~0xC) | ((k & 4) << 1) | ((k & 8) >> 1); return ((kk >> 3) * 4 + (c >> 5)) * 512 + ((kk & 7) * 32 + (c & 31)) * 2; }
__device__ __forceinline__ int v_rd_base(int lane) { return ((lane & 3) << 3) | (((lane >> 2) & 3) << 6) | (((lane >> 4) & 1) << 5) | (((lane >> 5) & 1) << 8); }
constexpr int v_rd_off(int d0, int ks, int half) { return d0 * 512 + ks * 4096 + half * 2048; }
template <int OFF> __device__ __forceinline__ s16x4 tr_read(int vb) {
  s16x4 r; asm volatile("ds_read_b64_tr_b16 %0, %1 offset:%2" : "=&v"(r) : "v"(vb), "i"(OFF) : "memory"); return r;
}
template <int D0> __device__ __forceinline__ void pv_one(f32x16& od, int vb, bf16x8 pa0, bf16x8 pa1, bf16x8 pa2, bf16x8 pa3) {
  const s16x4 l0 = tr_read<v_rd_off(D0, 0, 0)>(vb), h0 = tr_read<v_rd_off(D0, 0, 1)>(vb), l1 = tr_read<v_rd_off(D0, 1, 0)>(vb), h1 = tr_read<v_rd_off(D0, 1, 1)>(vb);
  const s16x4 l2 = tr_read<v_rd_off(D0, 2, 0)>(vb), h2 = tr_read<v_rd_off(D0, 2, 1)>(vb), l3 = tr_read<v_rd_off(D0, 3, 0)>(vb), h3 = tr_read<v_rd_off(D0, 3, 1)>(vb);
  asm volatile("s_waitcnt lgkmcnt(0)" ::: "memory"); SBAR();
#define PK(L, H) (bf16x8){L[0], L[1], L[2], L[3], H[0], H[1], H[2], H[3]}
  od = __builtin_amdgcn_mfma_f32_32x32x16_bf16(pa0, PK(l0, h0), od, 0, 0, 0);
  od = __builtin_amdgcn_mfma_f32_32x32x16_bf16(pa1, PK(l1, h1), od, 0, 0, 0);
  od = __builtin_amdgcn_mfma_f32_32x32x16_bf16(pa2, PK(l2, h2), od, 0, 0, 0);
  od = __builtin_amdgcn_mfma_f32_32x32x16_bf16(pa3, PK(l3, h3), od, 0, 0, 0);
#undef PK
}
__device__ __forceinline__ void pv_d0(f32x16* o, int vb, bf16x8 pa0, bf16x8 pa1, bf16x8 pa2, bf16x8 pa3) {
  pv_one<0>(o[0], vb, pa0, pa1, pa2, pa3); pv_one<1>(o[1], vb, pa0, pa1, pa2, pa3); pv_one<2>(o[2], vb, pa0, pa1, pa2, pa3); pv_one<3>(o[3], vb, pa0, pa1, pa2, pa3);
}

template <class Pol, int ldq, int ldk, int ldo>
__device__ __forceinline__ void attn_body(const bf16* __restrict__ Qb, const bf16* __restrict__ Kh, const bf16* __restrict__ Vh,
                                          unsigned short* __restrict__ Ob, int NT, char* lds, const Pol& pol) {
  const float sink_l2 = -INFINITY; float* const ml = nullptr; const long ldml = 0;
  const int tid = otid(), wid = tid >> 6, lane = tid & 63, r32 = lane & 31, hi = lane >> 5;
  bf16* V_lds = (bf16*)lds; bf16* K_lds = (bf16*)(lds + 2 * SHM_V);
  float* ws = (float*)(lds + 2 * SHM_V + 2 * SHM_K) + wid * 64; float* li_l = ws; float* al_l = ws + 32;
  float m_reg = -1e30f, l_reg = 0; f32x16 o[4] = {}; bf16x8 qr[8];
  const bf16* Qw = Qb + (long)(wid * QBLK + r32) * ldq + hi * 8;
#pragma unroll
  for (int d0 = 0; d0 < 8; ++d0) qr[d0] = *reinterpret_cast<const bf16x8*>(Qw + d0 * 16);
  const int sr = tid >> 4, sc = (tid & 15) * 8, vst0 = v_st(sr, sc), vst1 = v_st(32 + sr, sc);
  const int vb0 = (int)(uintptr_t)V_lds + v_rd_base(lane);
  struct { bf16x8 vs0, vs1, ks0, ks1; } sr_[2];
#define SLOAD(i, k0) do { sr_[i].vs0 = *reinterpret_cast<const bf16x8*>(&Vh[(long)((k0) + sr) * ldk + sc]); sr_[i].vs1 = *reinterpret_cast<const bf16x8*>(&Vh[(long)((k0) + 32 + sr) * ldk + sc]); \
    sr_[i].ks0 = *reinterpret_cast<const bf16x8*>(&Kh[(long)((k0) + sr) * ldk + sc]); sr_[i].ks1 = *reinterpret_cast<const bf16x8*>(&Kh[(long)((k0) + 32 + sr) * ldk + sc]); } while (0)
#define SWRITE(b, i) do { *(bf16x8*)((char*)V_lds + (b) * SHM_V + vst0) = sr_[i].vs0;          \
    *(bf16x8*)((char*)V_lds + (b) * SHM_V + vst1) = sr_[i].vs1; int kc = sc * 2;               \
    *(bf16x8*)((char*)K_lds + (b) * SHM_K + KSWZ(sr, kc)) = sr_[i].ks0;                       \
    *(bf16x8*)((char*)K_lds + (b) * SHM_K + KSWZ(32 + sr, kc)) = sr_[i].ks1; } while (0)
#define SWAIT() asm volatile("s_waitcnt vmcnt(4)" ::: "memory")
#define RESC(a) do { if (__any((a) < 1.f)) { if (hi == 0) al_l[r32] = (a); asm volatile("s_waitcnt lgkmcnt(0)" ::: "memory"); \
    _Pragma("unroll") for (int d = 0; d < 4; ++d) _Pragma("unroll") for (int r = 0; r < 16; ++r) o[d][r] *= al_l[crow(r, hi)]; } } while (0)
  f32x16 pA0, pA1, pB0, pB1; float mnA, mnB, alA, alB; bf16x8 pa0, pa1, pa2, pa3;
  constexpr int SE = 0, SO = 1;
  SLOAD(SE, 0); asm volatile("s_waitcnt vmcnt(0)" ::: "memory"); SWRITE(0, SE); __syncthreads();
  qkt(pA0, pA1, K_lds, qr, r32, hi); partialSM(pA0, pA1, m_reg, mnA, alA, pol, 0, hi);
  SLOAD(SO, KVBLK); if (2 < NT) SLOAD(SE, 2 * KVBLK);
  SWAIT(); SWRITE(1, SO); __syncthreads();
  for (int j = 1; j + 1 < NT; j += 2) {
    SBAR(); qkt(pB0, pB1, (bf16*)((char*)K_lds + SHM_K), qr, r32, hi);
    finishSM(pA0, pA1, alA, l_reg, pa0, pa1, pa2, pa3); SBAR();
    SLOAD(SO, (j + 2) * KVBLK); SBAR();
    pv_d0(o, vb0, pa0, pa1, pa2, pa3); partialSM(pB0, pB1, m_reg, mnB, alB, pol, j, hi);
    __syncthreads(); SWAIT(); SWRITE(0, SE);
    RESC(alB); __syncthreads();
    SBAR(); qkt(pA0, pA1, K_lds, qr, r32, hi);
    finishSM(pB0, pB1, alB, l_reg, pa0, pa1, pa2, pa3); SBAR();
    if (j + 3 < NT) SLOAD(SE, (j + 3) * KVBLK); SBAR();
    pv_d0(o, vb0 + (int)SHM_V, pa0, pa1, pa2, pa3); partialSM(pA0, pA1, m_reg, mnA, alA, pol, j + 1, hi);
    __syncthreads(); SWAIT(); SWRITE(1, SO);
    RESC(alA); __syncthreads();
  }
  SBAR(); qkt(pB0, pB1, (bf16*)((char*)K_lds + SHM_K), qr, r32, hi);
  finishSM(pA0, pA1, alA, l_reg, pa0, pa1, pa2, pa3); SBAR();
  pv_d0(o, vb0, pa0, pa1, pa2, pa3); partialSM(pB0, pB1, m_reg, mnB, alB, pol, NT - 1, hi);
  __syncthreads(); RESC(alB);
  finishSM(pB0, pB1, alB, l_reg, pa0, pa1, pa2, pa3); SBAR();
  pv_d0(o, vb0 + (int)SHM_V, pa0, pa1, pa2, pa3);
  constexpr float C = SCALE * 1.4426950408889634f;
  if (ml != nullptr && hi == 0) { float* mp = ml + (long)(wid * QBLK + r32) * ldml; mp[0] = m_reg * C; mp[1] = l_reg; }
  l_reg += __builtin_amdgcn_exp2f(sink_l2 - m_reg * C);
  if (hi == 0) li_l[r32] = l_reg; asm volatile("s_waitcnt lgkmcnt(0)" ::: "memory");
  float rli[16];
#pragma unroll
  for (int r = 0; r < 16; ++r) rli[r] = __builtin_amdgcn_rcpf(li_l[crow(r, hi)]);
  unsigned short* Ow = Ob + (long)(wid * QBLK) * ldo;
#pragma unroll
  for (int r = 0; r < 16; ++r) { int orow = crow(r, hi);
#pragma unroll
    for (int d0 = 0; d0 < 4; ++d0) { const float v = o[d0][r] * rli[r]; Ow[(long)orow * ldo + d0 * 32 + r32] = (unsigned short)(cvtpk(v, v) & 0xffffu); } }
#undef SLOAD
#undef SWRITE
#undef SWAIT
#undef RESC
}
template <class Pol>
__device__ __forceinline__ void attn_body_simple(const bf16* __restrict__ Qb, long ldq, const bf16* __restrict__ Kh, const bf16* __restrict__ Vh, long ldk,
                                                 unsigned short* __restrict__ Ob, long ldo, int NT, char* lds, const Pol& pol, float sink_l2, float* ml, long ldml) {
  const int tid = otid(), wid = tid >> 6, lane = tid & 63, r32 = lane & 31, hi = lane >> 5;
  bf16* V_lds = (bf16*)lds; bf16* K_lds = (bf16*)(lds + 2 * SHM_V);
  float* ws = (float*)(lds + 2 * SHM_V + 2 * SHM_K) + wid * 64; float* li_l = ws; float* al_l = ws + 32;
  float m_reg = -1e30f, l_reg = 0; f32x16 o[4] = {}; bf16x8 qr[8];
  const bf16* Qw = Qb + (long)(wid * QBLK + r32) * ldq + hi * 8;
#pragma unroll
  for (int d0 = 0; d0 < 8; ++d0) qr[d0] = *reinterpret_cast<const bf16x8*>(Qw + d0 * 16);
  const int sr = tid >> 4, sc = (tid & 15) * 8, vst0 = v_st(sr, sc), vst1 = v_st(32 + sr, sc);
  const int vb0 = (int)(uintptr_t)V_lds + v_rd_base(lane);
  const bf16* kp = Kh + (long)sr * ldk + sc; const bf16* vp = Vh + (long)sr * ldk + sc; const long step32 = 32 * ldk, step64 = 64 * ldk;
  struct { bf16x8 vs0, vs1, ks0, ks1; } sg[2];
#define LOADT(i) do { sg[i].vs0 = *reinterpret_cast<const bf16x8*>(vp); sg[i].vs1 = *reinterpret_cast<const bf16x8*>(vp + step32); \
    sg[i].ks0 = *reinterpret_cast<const bf16x8*>(kp); sg[i].ks1 = *reinterpret_cast<const bf16x8*>(kp + step32); kp += step64; vp += step64; } while (0)
#define WRITET(b, i) do { *(bf16x8*)((char*)V_lds + (b) * SHM_V + vst0) = sg[i].vs0; *(bf16x8*)((char*)V_lds + (b) * SHM_V + vst1) = sg[i].vs1; int kc = sc * 2; \
    *(bf16x8*)((char*)K_lds + (b) * SHM_K + KSWZ(sr, kc)) = sg[i].ks0; *(bf16x8*)((char*)K_lds + (b) * SHM_K + KSWZ(32 + sr, kc)) = sg[i].ks1; } while (0)
#define RESC(a) do { if (__any((a) < 1.f)) { if (hi == 0) al_l[r32] = (a); asm volatile("s_waitcnt lgkmcnt(0)" ::: "memory"); \
    _Pragma("unroll") for (int d = 0; d < 4; ++d) _Pragma("unroll") for (int r = 0; r < 16; ++r) o[d][r] *= al_l[crow(r, hi)]; } } while (0)
#define TILE(t, b) do { if (pol.live(t)) { f32x16 p0, p1; float mn, al; bf16x8 pa0, pa1, pa2, pa3; \
      qkt(p0, p1, (const bf16*)((const char*)K_lds + (b) * SHM_K), qr, r32, hi); partialSM(p0, p1, m_reg, mn, al, pol, t, hi); RESC(al); \
      finishSM(p0, p1, al, l_reg, pa0, pa1, pa2, pa3); SBAR(); pv_d0(o, vb0 + (b) * (int)SHM_V, pa0, pa1, pa2, pa3); } } while (0)
  LOADT(0); WRITET(0, 0); LOADT(1);
  for (int t = 0; t < NT; t += 2) {
    __syncthreads();
    if (t + 2 < NT) LOADT(0);
    TILE(t, 0);
    WRITET(1, 1);
    __syncthreads();
    if (t + 3 < NT) LOADT(1);
    TILE(t + 1, 1);
    if (t + 2 < NT) WRITET(0, 0);
  }
#undef TILE
  constexpr float C = SCALE * 1.4426950408889634f;
  if (ml != nullptr && hi == 0) { float* mp = ml + (long)(wid * QBLK + r32) * ldml; mp[0] = m_reg * C; mp[1] = l_reg; }
  l_reg += __builtin_amdgcn_exp2f(sink_l2 - m_reg * C);
  if (hi == 0) li_l[r32] = l_reg; asm volatile("s_waitcnt lgkmcnt(0)" ::: "memory");
  float rli[16];
#pragma unroll
  for (int r = 0; r < 16; ++r) rli[r] = __builtin_amdgcn_rcpf(li_l[crow(r, hi)]);
  unsigned short* Ow = Ob + (long)(wid * QBLK) * ldo;
#pragma unroll
  for (int r = 0; r < 16; ++r) { int orow = crow(r, hi);
#pragma unroll
    for (int d0 = 0; d0 < 4; ++d0) { const float v = o[d0][r] * rli[r]; Ow[(long)orow * ldo + d0 * 32 + r32] = (unsigned short)(cvtpk(v, v) & 0xffffu); } }
#undef LOADT
#undef WRITET
#undef RESC
}
}

#define XB_TMO      128
#define XB_XCNT(j)  (256  + 64 * (j))
#define XB_XSUB(j)  (1280 + 64 * (j))
#define XB_XGEN(j)  (2304 + 64 * (j))
#define XB_TOP      3328
#define XB_TOPGEN   3392
#define XCD_BAR_WORDS 3456
#define XB_SPIN_CAP (1u << 18)
#define LAS __attribute__((address_space(3)))

__device__ __forceinline__ unsigned xb_ld(unsigned* p)              { return __hip_atomic_load(p, __ATOMIC_RELAXED, __HIP_MEMORY_SCOPE_AGENT); }
__device__ __forceinline__ unsigned xb_add(unsigned* p, unsigned v) { return __hip_atomic_fetch_add(p, v, __ATOMIC_RELAXED, __HIP_MEMORY_SCOPE_AGENT); }
__device__ __forceinline__ unsigned xb_xcc_id() { return (unsigned)__builtin_amdgcn_s_getreg((3 << 11) | 20) & 0xFu; }
#define XB_SPIN(cond, bar) do { unsigned _sp = 0; while (cond) { __builtin_amdgcn_s_sleep(1); \
    if ((++_sp & 255u) == 0u) { if (xb_ld(&(bar)[XB_TMO])) break; if (_sp > XB_SPIN_CAP) { atomicAdd(&(bar)[XB_TMO], 1u); break; } } } } while (0)

struct XcdBarrier {
    unsigned* bar; unsigned x;
    volatile LAS unsigned* st;
};

__device__ __forceinline__ XcdBarrier xcd_barrier_post(unsigned* bar, volatile LAS unsigned* st) {
    XcdBarrier b; b.bar = bar; b.x = xb_xcc_id(); b.st = st;
    if (threadIdx.x == 0) (void)xb_add(&bar[XB_XCNT(b.x)], 1u);
    return b;
}
__device__ __forceinline__ void xcd_barrier_complete(unsigned* bar, unsigned x, unsigned& nloc, unsigned& nx) {
    const unsigned G = gridDim.x * gridDim.y * gridDim.z;
    unsigned sum, cnt, mine, sp = 0u;
    for (;;) {
        sum = 0u; cnt = 0u; mine = 0u;
#pragma unroll
        for (unsigned j = 0; j < 16; ++j) { const unsigned c = xb_ld(&bar[XB_XCNT(j)]); sum += c; cnt += (c > 0u) ? 1u : 0u; mine = (j == x) ? c : mine; }
        if (sum == G) break;
        __builtin_amdgcn_s_sleep(1);
        if ((++sp & 255u) == 0u) { if (xb_ld(&bar[XB_TMO])) break; if (sp > XB_SPIN_CAP) { atomicAdd(&bar[XB_TMO], 1u); break; } }
    }
    nloc = mine > 0u ? mine : 1u; nx = cnt > 0u ? cnt : 1u;
}

__device__ __forceinline__ void xcd_barrier(const XcdBarrier& b) {
    asm volatile("s_waitcnt vmcnt(0)" ::: "memory");
    __syncthreads();
    if (threadIdx.x == 0) {
        unsigned* bar = b.bar; asm volatile("" : "+s"(bar)); unsigned bx = b.x; asm volatile("" : "+s"(bx));
        __builtin_amdgcn_s_waitcnt(0);
        unsigned nloc = b.st[0], nx = b.st[1];
        if (nloc == 0u) { xcd_barrier_complete(bar, bx, nloc, nx); b.st[0] = nloc; b.st[1] = nx; }
        const unsigned old = xb_add(&bar[XB_XSUB(bx)], 1u);
        const unsigned gen = old / nloc;
        if (old + 1u == (gen + 1u) * nloc) {
            __builtin_amdgcn_fence(__ATOMIC_RELEASE, "agent");
            asm volatile("s_waitcnt vmcnt(0)" ::: "memory");
            const unsigned og = xb_add(&bar[XB_TOP], 1u);
            const unsigned tg = og / nx;
            if (og + 1u == (tg + 1u) * nx) xb_add(&bar[XB_TOPGEN], 1u);
            else XB_SPIN(xb_ld(&bar[XB_TOPGEN]) == tg, bar);
            __builtin_amdgcn_fence(__ATOMIC_ACQUIRE, "agent");
            xb_add(&bar[XB_XGEN(bx)], 1u);
            asm volatile("s_waitcnt vmcnt(0)" ::: "memory");
        } else {
            XB_SPIN(xb_ld(&bar[XB_XGEN(bx)]) == gen, bar);
            __builtin_amdgcn_fence(__ATOMIC_ACQUIRE, "agent");
            asm volatile("s_waitcnt vmcnt(0)" ::: "memory");
        }
    }
    __syncthreads();
}

typedef unsigned short u16;
typedef unsigned u32x4_t __attribute__((ext_vector_type(4)));
constexpr int LDS_BYTES = 131072 + 4096 + 8192;
__device__ __forceinline__ float bf2f(unsigned short v) { return __uint_as_float((unsigned)v << 16); }
__device__ __forceinline__ unsigned pk2(float a, float b) { return pg8::cvt_pk_bf16(a, b); }

typedef float f4v __attribute__((ext_vector_type(4)));
struct ConvDesc { const float* src; const float* gain; u16* dst; int K, N, mode, k0, n0; };
__device__ __forceinline__ int conv_ntiles(int L) { return 32 * (((L & 1) ? CD_IN : AB_IN) / 256) + 256 + 3 * 704; }
__device__ __forceinline__ ConvDesc conv_desc(const Params& p, int L, int t) {
  const int j = L >> 1; const bool odd = L & 1; const int nin = odd ? CD_IN : AB_IN; const int t_in = 32 * (nin / 256); ConvDesc d;
  if (t < t_in) { d.src = odd ? p.cd_w_in + (size_t)j * DM * CD_IN : p.ab_w_in + (size_t)j * DM * AB_IN; d.gain = p.attn_norm + L * DM; d.dst = p.wt_in() + L * WT_IN_L; d.K = DM; d.N = nin; d.mode = odd ? 4 : 3; }
  else if ((t -= t_in) < 256) { d.src = odd ? p.cd_w_out + (size_t)j * DM * DM : p.ab_w_out + (size_t)j * DM * DM; d.gain = nullptr; d.dst = p.wt_out() + L * WT_OUT_L; d.K = DM; d.N = DM; d.mode = 0; }
  else if ((t -= 256) < 704) { d.src = p.w_gate + (size_t)L * DM * FFN; d.gain = p.ffn_norm + L * DM; d.dst = p.wt_gu() + L * WT_GU_L; d.K = DM; d.N = FFN; d.mode = 1; }
  else if ((t -= 704) < 704) { d.src = p.w_up + (size_t)L * DM * FFN; d.gain = p.ffn_norm + L * DM; d.dst = p.wt_gu() + L * WT_GU_L; d.K = DM; d.N = FFN; d.mode = 2; }
  else { t -= 704; d.src = p.w_down + (size_t)L * FFN * DM; d.gain = nullptr; d.dst = p.wt_dn() + L * WT_DN_L; d.K = FFN; d.N = DM; d.mode = 0; }
  const int ntn = d.N / 256, kt = t / ntn, nt = t - kt * ntn; d.k0 = kt * 64; d.n0 = nt * 256; return d;
}
__device__ __forceinline__ void conv_load(const ConvDesc& d, f4v (&v)[4][2], float& g0, float& g1, int tid) {
  const int rp = tid >> 4, cc = (tid & 15) * 4;
#pragma unroll
  for (int sub = 0; sub < 4; ++sub)
#pragma unroll
    for (int i = 0; i < 2; ++i) v[sub][i] = __builtin_nontemporal_load((const f4v*)(d.src + (size_t)(d.k0 + 2 * rp + i) * d.N + d.n0 + sub * 64 + cc));
  g0 = d.gain ? d.gain[d.k0 + 2 * rp] : 1.0f; g1 = d.gain ? d.gain[d.k0 + 2 * rp + 1] : 1.0f;
}
__device__ __forceinline__ void conv_stage(const f4v (&v)[4][2], float g0, float g1, char* shm, int tid) {
  unsigned* tile = (unsigned*)shm;
  const int rp = tid >> 4, cc = (tid & 15) * 4;
#pragma unroll
  for (int sub = 0; sub < 4; ++sub) { unsigned* tp = tile + sub * (32 * 65) + rp * 65 + cc;
#pragma unroll
    for (int e = 0; e < 4; ++e) tp[e] = pk2(v[sub][0][e] * g0, v[sub][1][e] * g1); }
}
__device__ __forceinline__ void conv_store(const ConvDesc& d, char* shm, int tid) {
  const unsigned* tile = (const unsigned*)shm; const int n = tid >> 3, kq = tid & 7;
#pragma unroll
  for (int sub = 0; sub < 4; ++sub) { u32x4_t w;
#pragma unroll
    for (int j = 0; j < 4; ++j) w[j] = tile[sub * (32 * 65) + (4 * kq + j) * 65 + n];
    const int cg = d.n0 + sub * 64 + n; int drow;
    if (d.mode == 0) drow = cg; else if (d.mode <= 2) drow = 256 * (cg >> 7) + (cg & 127) + (d.mode == 2 ? 128 : 0);
    else { const int head = cg >> 7, dd_ = cg & 127; int s_ = dd_;
      if (d.mode == 3) { if (head >= 24 && head < 34) { const int dd = dd_ & 63; s_ = 2 * ((dd & 31) + (dd_ >= 64 ? 32 : 0)) + (dd >> 5); } }
      else { if ((head < 16 || (head >= 20 && head < 36)) && dd_ < 32) s_ = 2 * (dd_ & 15) + (dd_ >> 4); }
      drow = head * 128 + s_; }
    *(u32x4_t*)(d.dst + (size_t)drow * d.K + d.k0 + 8 * kq) = w; }
}
__device__ __forceinline__ void conv_range(const Params& p, int L, int first, int hi, int step, char* shm) {
  int t = first; if (t >= hi) return;
  const int tid = otid(); f4v v[4][2]; float g0, g1;
  ConvDesc d = conv_desc(p, L, t); conv_load(d, v, g0, g1, tid);
  for (;;) {
    conv_stage(v, g0, g1, shm, tid); __syncthreads();
    const int tn = t + step; const bool more = tn < hi; ConvDesc dn = d;
    if (more) { dn = conv_desc(p, L, tn); conv_load(dn, v, g0, g1, tid); }
    conv_store(d, shm, tid); __syncthreads();
    if (!more) break;
    d = dn; t = tn;
  }
}
__device__ __forceinline__ int idle_first(int nwg, int G) { return nwg - ((nwg + G - 1) / G - 1) * G; }
__device__ __forceinline__ void conv_filler(const Params& p, int l, int part, char* shm) {
  const int G = ogdim(), c = obid();
  const int nwg = part == 0 ? 32 * (((l & 1) ? CD_IN : AB_IN) / 256) : 32 * (2 * FFN / 256);
  int first = idle_first(nwg, G), n = G - first;
  if (n == 0) { first = 0; n = G; }
  if (c < first) return;
  const int tin = 32 * (((l & 1) ? CD_IN : AB_IN) / 256), o_out = tin, o_gate = tin + 256, o_down = tin + 256 + 1408, T = conv_ntiles(l);
  if (part == 0) conv_range(p, l, (l == 0 ? o_out : o_gate) + (c - first), o_down, n, shm);
  else { conv_range(p, l, o_down + (c - first), T, n, shm);
    if (l + 1 < DEPTH) { const int tin1 = 32 * ((((l + 1) & 1) ? CD_IN : AB_IN) / 256); conv_range(p, l + 1, c - first, tin1 + 256, n, shm); } }
}
__device__ __forceinline__ void phase_prologue(const Params& p, char* shm) {
  const int tid = otid(), bid = obid(), gdim = ogdim(), gtid = bid * 512 + tid, gsz = gdim * 512;
  for (int i = gtid; i < 7 * NTOK; i += gsz) p.sumsq()[NTOK + i] = 0ull;
  { const int wid = tid >> 6, lane = tid & 63;
    for (int row = bid * 8 + wid; row < NTOK; row += gdim * 8) { const float* xr = p.x + (size_t)row * DM; u16* brow = p.xb() + (size_t)row * DM; float ss = 0.f;
#pragma unroll
      for (int i = 0; i < 4; ++i) { const int c = (i * 64 + lane) * 8; const float4 a = *(const float4*)(xr + c), b = *(const float4*)(xr + c + 4);
        u32x4_t w = {pk2(a.x, a.y), pk2(a.z, a.w), pk2(b.x, b.y), pk2(b.z, b.w)}; *(u32x4_t*)(brow + c) = w;
        ss += a.x * a.x + a.y * a.y + a.z * a.z + a.w * a.w + b.x * b.x + b.y * b.y + b.z * b.z + b.w * b.w; }
#pragma unroll
      for (int s = 32; s >= 1; s >>= 1) ss += __shfl_xor(ss, s);
      if (lane == 0) p.sumsq()[row] = (unsigned long long)(ss * 16777216.0f); } }
  conv_range(p, 0, bid, 32 * (AB_IN / 256), gdim, shm);
}

__device__ __forceinline__ void phase_attn_even(const Params& p, int l, char* shm) {
  using at::bf16; const int j = l >> 1; const bf16* H = (const bf16*)p.h(); const long LD = AB_IN;
  for (int it = obid(); it < 512; it += ogdim()) {
    __syncthreads();
#ifndef SUBSEL
#define SUBSEL 3
#endif
    if (it < 256) { if (SUBSEL & 1) {
      const int xc = it & 7, jj = it >> 3, pr = xc >> 1, b = pr >> 1, hq = (pr & 1) * 4 + (jj & 3), qb = (xc & 1) * 8 + (jj >> 2); const long t0 = (long)b * SEQ;
      at::attn_body<at::PolNone, AB_IN, AB_IN, DM>(H + (t0 + qb * 256) * LD + 3072 + hq * 128, H + t0 * LD + 4096 + (hq >> 2) * 128, H + t0 * LD + 4352 + (hq >> 2) * 128,
                                 p.ao() + (size_t)(t0 + qb * 256) * DM + 1024 + hq * 128, 64, shm, at::PolNone{});
    } } else if (SUBSEL & 2) {
      const int i2 = it - 256, R = i2 & 15, hh = (i2 >> 4) & 7, b = i2 >> 7; const long t0 = (long)b * SEQ;
      float* rl = (float*)(shm + at::SHM_ATTN); const float* rg = p.a_rpb + (size_t)(j * 8 + hh) * 465;
      const int tq = otid(); for (int i = tq; i < 465; i += 512) rl[i] = rg[i];
      const int qi = (tq >> 6) * 32 + (tq & 31); const int rstart = min(max(4 * R - 4, 0), 52);
      at::PolNA pol{4 * R + (qi >> 6), qi & 63, rstart, rl};
      at::attn_body_simple<at::PolNA>(H + (t0 + R * 256) * LD + hh * 128, LD, H + (t0 + rstart * 64) * LD + 1024 + hh * 128, H + (t0 + rstart * 64) * LD + 2048 + hh * 128, LD,
                               p.ao() + (size_t)(t0 + R * 256) * DM + hh * 128, DM, 12, shm, pol, -INFINITY, nullptr, 0);
    }
  }
}
__device__ __forceinline__ void phase_attn_odd(const Params& p, int l, char* shm) {
  using at::bf16; const int j = l >> 1; const bf16* H = (const bf16*)p.h(); const long LD = CD_IN;
  for (int pos = obid(); pos < 768; pos += ogdim()) {
    __syncthreads();
    const int tq = otid(); const int qi = (tq >> 6) * 32 + (tq & 31);
    int it; { const int w = pos & 255, r = pos >> 8;
      if (r == 0) it = w; else if (r == 1) it = w < 128 ? 256 + w : 384 + (w - 128); else it = w < 128 ? 640 + w : 384 + 128 + (w - 128); }
    if (it < 384) {
      const int qb = it & 15, hq = (it >> 4) % 12, b = it / 192; const long t0 = (long)b * SEQ; const int q0 = qb * 256, ks = min(max(q0 - 128, 0), SEQ - 512), kv = hq / 3;
      at::PolWin pol{q0 + qi, ks, 128, q0 + (tq >> 6) * 32};
      at::attn_body_simple<at::PolWin>(H + (t0 + q0) * LD + hq * 128, LD, H + (t0 + ks) * LD + 1536 + kv * 128, H + (t0 + ks) * LD + 2048 + kv * 128, LD,
                                p.ao() + (size_t)(t0 + q0) * DM + hq * 128, DM, 8, shm, pol, p.c_sink[j * 12 + hq] * 1.4426950408889634f, nullptr, 0);
    } else {
      int e, g, s, b; if (it < 640) { const int i2 = it - 384; e = i2 & 15; g = (i2 >> 4) & 1; s = (i2 >> 5) & 3; b = i2 >> 7; } else { const int i2 = it - 640; e = i2 & 15; g = 2; s = (i2 >> 4) & 3; b = i2 >> 6; }
      const long t0 = (long)b * SEQ;
      const int d = g == 0 ? 1 : (g == 1 ? 4 : 16); const int rho = g == 0 ? 0 : (g == 1 ? (e >> 2) : e), ub = g == 0 ? e : (g == 1 ? (e & 3) : 0);
      const int sp = SEQ / d, u0 = ub * 256, nt = g == 2 ? 4 : 6, ks = min(max(u0 - 64, 0), sp - nt * 64);
      at::PolWin pol{u0 + qi, ks, 64, u0 + (tq >> 6) * 32};
      const long qtok = t0 + rho + (long)d * u0, ktok = t0 + rho + (long)d * ks;
      at::attn_body_simple<at::PolWin>(H + qtok * LD + 2560 + (g * 4 + s) * 128, LD * d, H + ktok * LD + 4096 + s * 128, H + ktok * LD + 4608 + s * 128, LD * d,
                                p.dpart() + ((size_t)g * NTOK + qtok) * 512 + s * 128, 512L * d, nt, shm, pol, -INFINITY,
                                p.dml() + (((size_t)g * NTOK + qtok) * 4 + s) * 2, 8L * d);
    }
  }
}
__device__ __forceinline__ void phase_merge(const Params& p) {
  const int tid = otid(), lj = tid & 15;
  constexpr int U = 4;
  for (int rid0 = obid() * (32 * U) + (tid >> 4); rid0 < NTOK * 4; rid0 += ogdim() * (32 * U)) {
    float2 ml[U][3]; u32x4_t raw[U][3];
#pragma unroll
    for (int u = 0; u < U; ++u) { const int rid = rid0 + 32 * u, tok = rid >> 2, s = rid & 3;
#pragma unroll
      for (int g = 0; g < 3; ++g) { ml[u][g] = *(const float2*)(p.dml() + (((size_t)g * NTOK + tok) * 4 + s) * 2);
        raw[u][g] = *(const u32x4_t*)(p.dpart() + ((size_t)g * NTOK + tok) * 512 + s * 128 + lj * 8); } }
#pragma unroll
    for (int u = 0; u < U; ++u) { const int rid = rid0 + 32 * u, tok = rid >> 2, s = rid & 3;
      const float M = fmaxf(ml[u][0].x, fmaxf(ml[u][1].x, ml[u][2].x)); float w[3], ws = 0.f;
#pragma unroll
      for (int g = 0; g < 3; ++g) { w[g] = __builtin_amdgcn_exp2f(ml[u][g].x - M) * ml[u][g].y; ws += w[g]; }
      const float inv = 1.0f / ws; float acc[8] = {0.f, 0.f, 0.f, 0.f, 0.f, 0.f, 0.f, 0.f};
#pragma unroll
      for (int g = 0; g < 3; ++g) { const float wg = w[g] * inv;
#pragma unroll
        for (int e = 0; e < 4; ++e) { acc[2 * e] += wg * __uint_as_float(raw[u][g][e] << 16); acc[2 * e + 1] += wg * __uint_as_float(raw[u][g][e] & 0xffff0000u); } }
      u32x4_t o = {pk2(acc[0], acc[1]), pk2(acc[2], acc[3]), pk2(acc[4], acc[5]), pk2(acc[6], acc[7])};
      *(u32x4_t*)(p.ao() + (size_t)tok * DM + 1536 + s * 128 + lj * 8) = o; }
  }
}

template <class Epi> __device__ __forceinline__ void run_gemm(const u16* A, const u16* Bt, int N, int K, const Epi& E, char* shm) {
  pg8::Gemm g{A, Bt, NTOK, N, K}; pg8::StaticOrder S; S.init(NTOK, N, ogdim(), obid());
  pg8::gemm_phase<Epi, pg8::StaticOrder, false>((PG8_LAS unsigned char*)shm, g, S, E, nullptr);
}

__device__ __forceinline__ Params load_params() {
  const __attribute__((address_space(4))) Params* q = (const __attribute__((address_space(4))) Params*)__builtin_amdgcn_kernarg_segment_ptr();
  asm volatile("" : "+s"(q));
#if defined(__HIP_DEVICE_COMPILE__)
  return *q;
#else
  return Params{};
#endif
}
constexpr int NPHASE = 1 + 7 * DEPTH;
__global__ void __launch_bounds__(512) mega(Params p_unused) {
  extern __shared__ __attribute__((aligned(16))) char shm[];
  cg::grid_group grid = cg::this_grid();
  if (load_params().ws == nullptr) grid.sync();
  volatile LAS unsigned* xst = (volatile LAS unsigned*)(shm + 131072 + 2048);
  if (threadIdx.x < 4) xst[threadIdx.x] = 0u;
  __syncthreads();
  const XcdBarrier xbar = xcd_barrier_post(load_params().bar(), xst);
  { const Params p = load_params(); phase_prologue(p, shm); }
  xcd_barrier(xbar);
  for (int l = 0; l < DEPTH; ++l) {
    const bool odd = l & 1; const int nin = odd ? CD_IN : AB_IN;
    { const Params p = load_params(); const int j = l >> 1;
      run_gemm(p.xb(), p.wt_in() + l * WT_IN_L, nin, DM, pg8::EpiHN{p.h(), nin, p.sumsq() + (2 * l) * NTOK, (odd ? p.c_qn : p.a_qn) + j * 128, (odd ? p.c_kn : p.a_kn) + j * 128,
               (odd ? p.d_qn : p.b_qn) + j * 128, (odd ? p.d_kn : p.b_kn) + j * 128, odd ? 1 : 0, (PG8_LAS float*)(shm + 131072 + 4096)}, shm);
      conv_filler(p, l, 0, shm); }
    xcd_barrier(xbar);
    { const Params p = load_params(); if (odd) phase_attn_odd(p, l, shm); else phase_attn_even(p, l, shm); }
    xcd_barrier(xbar);
    if (odd) { { const Params p = load_params(); phase_merge(p); } xcd_barrier(xbar); }
    { const Params p = load_params(); run_gemm(p.ao(), p.wt_out() + l * WT_OUT_L, DM, DM, pg8::EpiResT<false>{nullptr, p.xb(), p.sumsq() + (2 * l + 1) * NTOK}, shm); }
    xcd_barrier(xbar);
    { const Params p = load_params(); run_gemm(p.xb(), p.wt_gu() + l * WT_GU_L, 2 * FFN, DM, pg8::EpiGU{p.hid(), p.sumsq() + (2 * l + 1) * NTOK}, shm); conv_filler(p, l, 1, shm); }
    xcd_barrier(xbar);
    { const Params p = load_params();
      if (l + 1 < DEPTH) run_gemm(p.hid(), p.wt_dn() + l * WT_DN_L, DM, FFN, pg8::EpiResT<false>{nullptr, p.xb(), p.sumsq() + (2 * l + 2) * NTOK}, shm);
      else run_gemm(p.hid(), p.wt_dn() + l * WT_DN_L, DM, FFN, pg8::EpiResT<true>{p.xres, p.xb(), nullptr}, shm); }
    if (l + 1 < DEPTH) xcd_barrier(xbar);
  }
}

extern "C" void kernel_launch(void* const* d_in, const int* in_sizes, int n_in, void* d_out, int out_size, void* d_ws, size_t ws_size, hipStream_t stream) {
  Params p; memset(&p, 0, sizeof(p));
  const float** pf = (const float**)&p;
  for (int i = 0; i < 20; ++i) pf[i] = (const float*)d_in[i];
  p.xres = (float*)d_out;
  p.ws = (char*)d_ws; const size_t off = WS_END;
  static int grid_blocks = 0;
  if (!grid_blocks) {
    if (off > ws_size) { fprintf(stderr, "kernel_launch: ws too small: need %zu have %zu\n", off, ws_size); return; }
    if (hipFuncSetAttribute((const void*)mega, hipFuncAttributeMaxDynamicSharedMemorySize, LDS_BYTES) != hipSuccess) { fprintf(stderr, "kernel_launch: LDS attribute failed\n"); return; }
    int dev = 0, cus = 0, per_cu = 0; hipGetDevice(&dev); hipDeviceGetAttribute(&cus, hipDeviceAttributeMultiprocessorCount, dev);
    hipOccupancyMaxActiveBlocksPerMultiprocessor(&per_cu, mega, 512, LDS_BYTES);
    if (per_cu < 1) { fprintf(stderr, "kernel_launch: occupancy 0\n"); return; }
    grid_blocks = cus;
  }
  hipMemsetAsync((char*)d_ws + O_BAR, 0, (size_t)XCD_BAR_WORDS * 4, stream);
  void* args[] = {&p};
  hipError_t e = hipLaunchCooperativeKernel((const void*)mega, dim3(grid_blocks), dim3(512), args, LDS_BYTES, stream);
  if (e != hipSuccess) fprintf(stderr, "cooperative launch failed: %s (grid %d)\n", hipGetErrorString(e), grid_blocks);
}
```

```cpp
#include <hip/hip_runtime.h>
#include <hip/hip_bf16.h>
#include <hip/hip_cooperative_groups.h>
#include <cstdio>
#include <cstring>
#include <cstdint>
namespace cg = cooperative_groups;
__device__ __forceinline__ int otid() { int t = threadIdx.x; asm volatile("" : "+v"(t)); return t; }
__device__ __forceinline__ int obid() { int t = blockIdx.x; asm volatile("" : "+s"(t)); return t; }
__device__ __forceinline__ int ogdim() { int t = gridDim.x; asm volatile("" : "+s"(t)); return t; }

constexpr int DM = 2048, SEQ = 4096, NTOK = 8192, DEPTH = 4;
constexpr int AB_IN = 4608, CD_IN = 5120, FFN = 5632;
constexpr float EPS = 1e-6f;


constexpr size_t WT_IN_L = (size_t)CD_IN * DM, WT_OUT_L = (size_t)DM * DM, WT_GU_L = (size_t)2 * FFN * DM, WT_DN_L = (size_t)DM * FFN;
constexpr size_t al256(size_t x) { return (x + 255) / 256 * 256; }
constexpr size_t O_WT_IN = 0, O_WT_OUT = O_WT_IN + al256(DEPTH * WT_IN_L * 2), O_WT_GU = O_WT_OUT + al256(DEPTH * WT_OUT_L * 2), O_WT_DN = O_WT_GU + al256(DEPTH * WT_GU_L * 2),
  O_XB = O_WT_DN + al256(DEPTH * WT_DN_L * 2), O_H = O_XB + al256((size_t)NTOK * DM * 2), O_AO = O_H + al256((size_t)NTOK * CD_IN * 2), O_HID = O_AO + al256((size_t)NTOK * DM * 2),
  O_DPART = O_HID + al256((size_t)NTOK * FFN * 2), O_DML = O_DPART + al256((size_t)3 * NTOK * 512 * 2), O_SUMSQ = O_DML + al256((size_t)3 * NTOK * 4 * 2 * 4), O_TAB_AX = O_SUMSQ + al256((size_t)8 * NTOK * 8),
  O_TAB_PR = O_TAB_AX + al256(64 * 32 * 2 * 4), O_BAR = O_TAB_PR + al256((size_t)SEQ * 16 * 2 * 4), WS_END = O_BAR + al256(4096 * 4);
__device__ const float kInvRevAxF[32] = {0.15915494309189535f, 0.11934937021124886f, 0.089499401608891013f, 0.067115083005227255f, 0.050329212104487035f, 0.037741584717419771f, 0.028302195830623399f, 0.02122365276477766f, 0.015915494309189534f, 0.011934937021124886f, 0.0089499401608891024f, 0.0067115083005227253f, 0.0050329212104487037f, 0.0037741584717419772f, 0.0028302195830623399f, 0.0021223652764777662f, 0.0015915494309189536f, 0.0011934937021124885f, 0.00089499401608891024f, 0.0006711508300522726f, 0.00050329212104487033f, 0.00037741584717419774f, 0.00028302195830623395f, 0.00021223652764777661f, 0.00015915494309189535f, 0.00011934937021124886f, 8.9499401608891018e-05f, 6.7115083005227254e-05f, 5.0329212104487035e-05f, 3.7741584717419777e-05f, 2.8302195830623396e-05f, 2.1223652764777659e-05f};
__device__ const float kInvRevPrF[16] = {0.15915494309189535f, 0.070086521587798503f, 0.03086376340470123f, 0.013591370636193905f, 0.0059851857127137054f, 0.002635675898667414f, 0.001160663641240061f, 0.00051111750453754386f, 0.00022507907903927653f, 9.9117309369019355e-05f, 4.3647952792802891e-05f, 1.9221100684944863e-05f, 8.4643308082414014e-06f, 3.7274086019153519e-06f, 1.6414262627950345e-06f, 7.2282930688328648e-07f};
struct Params {
  const float *x, *attn_norm, *ffn_norm, *ab_w_in, *ab_w_out, *a_qn, *a_kn, *a_rpb, *b_qn, *b_kn,
              *cd_w_in, *cd_w_out, *c_qn, *c_kn, *c_sink, *d_qn, *d_kn, *w_gate, *w_up, *w_down;
  float* xres;
  char* ws;
  __device__ __forceinline__ unsigned short* wt_in() const { return (unsigned short*)(ws + O_WT_IN); }
  __device__ __forceinline__ unsigned short* wt_out() const { return (unsigned short*)(ws + O_WT_OUT); }
  __device__ __forceinline__ unsigned short* wt_gu() const { return (unsigned short*)(ws + O_WT_GU); }
  __device__ __forceinline__ unsigned short* wt_dn() const { return (unsigned short*)(ws + O_WT_DN); }
  __device__ __forceinline__ unsigned short* xb() const { return (unsigned short*)(ws + O_XB); }
  __device__ __forceinline__ unsigned short* h() const { return (unsigned short*)(ws + O_H); }
  __device__ __forceinline__ unsigned short* ao() const { return (unsigned short*)(ws + O_AO); }
  __device__ __forceinline__ unsigned short* hid() const { return (unsigned short*)(ws + O_HID); }
  __device__ __forceinline__ unsigned short* dpart() const { return (unsigned short*)(ws + O_DPART); }
  __device__ __forceinline__ float* dml() const { return (float*)(ws + O_DML); }
  __device__ __forceinline__ unsigned long long* sumsq() const { return (unsigned long long*)(ws + O_SUMSQ); }
  __device__ __forceinline__ unsigned* bar() const { return (unsigned*)(ws + O_BAR); }
};

namespace pg8 {
#define PG8_LAS __attribute__((address_space(3)))
typedef unsigned short bf16_t;
typedef short bf16x8 __attribute__((ext_vector_type(8)));
typedef float f32x4 __attribute__((ext_vector_type(4)));
typedef unsigned u32x4 __attribute__((ext_vector_type(4)));
constexpr int BM = 256, BK = 64, HALF = 128, HTB = HALF * BK * 2  , STAGE_BYTES = 8 * HTB, NXCD = 8, WGM = 8;

__host__ __device__ __forceinline__ int lds_byte(int r, int c) { const int st = (r >> 4) * 2 + (c >> 5), rr = r & 15, cc = c & 31, ob = rr * 64 + cc * 2; return st * 1024 + (ob ^ (((ob >> 9) & 1) << 5)); }
__host__ __device__ __forceinline__ void stage_rc(int b, int& R, int& C) { const int st = b / 1024, sb = b % 1024, swz = sb ^ (((sb >> 9) & 1) << 5); R = (st >> 1) * 16 + swz / 64; C = (st & 1) * 32 + (swz % 64) / 2; }
__host__ __device__ __forceinline__ int perm32(int rho) { const int n = rho >> 4, i = rho & 15; return 8 * (i >> 2) + 4 * n + (i & 3); }

struct Unit { int pm, pn; };
struct Gemm { const bf16_t* A; const bf16_t* Bt; int M, N, K; };

struct StaticOrder {
    int nM, nN, nwg, G, c;
    __host__ __device__ void init(int M, int N, int G_, int c_) { nM = M / BM; nN = N / BM; nwg = nM * nN; G = G_; c = c_; }
    __host__ __device__ bool next(int i, Unit& u) const {
        const long L = (long)i * G + c; if (L >= nwg) return false;
        int wgid = (int)L; { const int q = nwg / NXCD, r = nwg % NXCD, xcd = wgid % NXCD, off = wgid / NXCD; wgid = (xcd < r ? xcd * (q + 1) : r * (q + 1) + (xcd - r) * q) + off; }
        const int nig = WGM * nN, gid = wgid / nig, fm = gid * WGM, gsz = (nM - fm) < WGM ? (nM - fm) : WGM;
        u.pm = fm + ((wgid % nig) % gsz); u.pn = (wgid % nig) / gsz; return true;
    }
    __device__ __forceinline__ void a_ready(const Unit&) const {}
    __device__ __forceinline__ void done(const Unit&) const {}
};

__device__ __forceinline__ unsigned cvt_pk_bf16(float lo, float hi) { unsigned r; asm volatile("v_cvt_pk_bf16_f32 %0, %1, %2" : "=v"(r) : "v"(lo), "v"(hi)); return r; }

__device__ __forceinline__ u32x4 lane_t416(u32x4 w, int srcb) {
    u32x4 r; r[0] = (unsigned)__builtin_amdgcn_ds_bpermute(srcb, (int)w[0]); r[1] = (unsigned)__builtin_amdgcn_ds_bpermute(srcb, (int)w[1]);
    r[2] = (unsigned)__builtin_amdgcn_ds_bpermute(srcb, (int)w[2]); r[3] = (unsigned)__builtin_amdgcn_ds_bpermute(srcb, (int)w[3]); return r;
}
struct EpiHN {
    static constexpr bool PERM = true, AFTER_DRAIN = false;
    bf16_t* O; int ldc; const unsigned long long* ss; const float *qn0, *kn0, *qn1, *kn1; int odd; PG8_LAS float* red;
    __device__ __forceinline__ void operator()(const f32x4 (&acc)[2][2][4][2], const Unit& u, int, int, int, int) const {
        const int t_ = otid(), wid_ = t_ >> 6, wr = wid_ >> 2, wc = wid_ & 3, fr = t_ & 15, fq = (t_ >> 4) & 3, ln = t_ & 63, fr2 = ln >> 2, fq2 = ln & 3;
        const int srcb = 4 * ((ln & 3) * 16 + (ln >> 2));
        const int row0 = u.pm * BM + wr * 64, head0 = 2 * u.pn;
        const float* gw; int rope;
        if (!odd) { rope = 0; if (head0 < 8) gw = qn0; else if (head0 < 16) gw = kn0; else if (head0 < 24) gw = nullptr; else if (head0 < 32) { gw = qn1; rope = 1; } else if (head0 < 34) { gw = kn1; rope = 1; } else gw = nullptr; }
        else { rope = 2; if (head0 < 12) gw = qn0; else if (head0 < 16) gw = kn0; else if (head0 < 20) gw = nullptr; else if (head0 < 32) gw = qn1; else if (head0 < 36) gw = kn1; else gw = nullptr; }
        unsigned long long sv[2][4];
#pragma unroll
        for (int ai = 0; ai < 2; ++ai)
#pragma unroll
            for (int m = 0; m < 4; ++m) sv[ai][m] = ss[row0 + fr + ai * HALF + m * 16];
        float rs[2][4];
#pragma unroll
        for (int ai = 0; ai < 2; ++ai)
#pragma unroll
            for (int m = 0; m < 4; ++m) rs[ai][m] = __builtin_amdgcn_rsqf((float)sv[ai][m] * (1.0f / (2048.0f * 16777216.0f)) + 1e-6f);
        if (gw == nullptr) {
#pragma unroll
            for (int ai = 0; ai < 2; ++ai)
#pragma unroll
                for (int m = 0; m < 4; ++m) { bf16_t* rowp = O + (size_t)(row0 + fr2 + ai * HALF + m * 16) * ldc + u.pn * BM + wc * 32 + 8 * fq2;
#pragma unroll
                    for (int bj = 0; bj < 2; ++bj) { const f32x4 v0 = acc[ai][bj][m][0] * rs[ai][m], v1 = acc[ai][bj][m][1] * rs[ai][m];
                        u32x4 w = {cvt_pk_bf16(v0[0], v0[1]), cvt_pk_bf16(v0[2], v0[3]), cvt_pk_bf16(v1[0], v1[1]), cvt_pk_bf16(v1[2], v1[3])};
                        *(u32x4*)(rowp + bj * HALF) = lane_t416(w, srcb); } }
            return;
        }
        const int c8 = wc * 32 + fq * 8;
        float gwv[8], fqv[4];
#pragma unroll
        for (int e = 0; e < 8; ++e) { const int s_ = c8 + e, t = s_ >> 1;
            const int dim = rope == 1 ? ((t < 32 ? t : t + 32) + 32 * (s_ & 1)) : (rope == 2 && s_ < 32) ? (t + 16 * (s_ & 1)) : s_;
            gwv[e] = gw[dim]; }
        const bool dorope = (rope == 1) || (rope == 2 && wc == 0);
#pragma unroll
        for (int k = 0; k < 4; ++k) { const int t = (c8 >> 1) + k; fqv[k] = rope == 1 ? kInvRevAxF[t & 31] : kInvRevPrF[t & 15]; }
#pragma unroll
        for (int ai = 0; ai < 2; ++ai)
#pragma unroll
            for (int m = 0; m < 4; ++m)
#pragma unroll
                for (int bj = 0; bj < 2; ++bj) { float p = 0.f;
#pragma unroll
                    for (int n = 0; n < 2; ++n)
#pragma unroll
                        for (int j = 0; j < 4; ++j) { const float v = acc[ai][bj][m][n][j] * rs[ai][m]; p += v * v; }
                    p += __shfl_xor(p, 16); p += __shfl_xor(p, 32);
                    if (fq == 0) red[((wr * 128 + (ai * 4 + m) * 16 + fr) * 2 + bj) * 4 + wc] = p; }
        asm volatile("s_waitcnt lgkmcnt(0)" ::: "memory"); __builtin_amdgcn_s_barrier(); asm volatile("" ::: "memory");
#pragma unroll
        for (int ai = 0; ai < 2; ++ai)
#pragma unroll
            for (int m = 0; m < 4; ++m) { const int pos = (row0 + fr + ai * HALF + m * 16) & 4095; float cs[4], sn[4];
                if (dorope) { const float P = rope == 1 ? (float)(wc < 2 ? (pos >> 6) : (pos & 63)) : (float)pos;
#pragma unroll
                    for (int k = 0; k < 4; ++k) { const float x = __builtin_amdgcn_fractf(P * fqv[k]); cs[k] = __builtin_amdgcn_cosf(x); sn[k] = __builtin_amdgcn_sinf(x); } }
                bf16_t* rowp = O + (size_t)(row0 + fr2 + ai * HALF + m * 16) * ldc + u.pn * BM + wc * 32 + 8 * fq2;
#pragma unroll
                for (int bj = 0; bj < 2; ++bj) { const f32x4 r4 = *(const PG8_LAS f32x4*)(red + ((wr * 128 + (ai * 4 + m) * 16 + fr) * 2 + bj) * 4);
                    const float rsh = __builtin_amdgcn_rsqf((r4[0] + r4[1] + r4[2] + r4[3]) * (1.0f / 128.0f) + 1e-6f) * rs[ai][m];
                    float y[8];
#pragma unroll
                    for (int n = 0; n < 2; ++n)
#pragma unroll
                        for (int j = 0; j < 4; ++j) y[n * 4 + j] = acc[ai][bj][m][n][j] * rsh * gwv[n * 4 + j];
                    if (dorope) {
#pragma unroll
                        for (int k = 0; k < 4; ++k) { const float x1 = y[2 * k], x2 = y[2 * k + 1]; y[2 * k] = x1 * cs[k] - x2 * sn[k]; y[2 * k + 1] = x1 * sn[k] + x2 * cs[k]; } }
                    u32x4 w = {cvt_pk_bf16(y[0], y[1]), cvt_pk_bf16(y[2], y[3]), cvt_pk_bf16(y[4], y[5]), cvt_pk_bf16(y[6], y[7])};
                    *(u32x4*)(rowp + bj * HALF) = lane_t416(w, srcb); } }
    }
};
struct EpiGU {
    static constexpr bool PERM = true, AFTER_DRAIN = false;
    bf16_t* O; const unsigned long long* ss;
    __device__ __forceinline__ void operator()(const f32x4 (&acc)[2][2][4][2], const Unit& u, int, int, int, int) const {
        const int t_ = otid(), wid_ = t_ >> 6, wr = wid_ >> 2, wc = wid_ & 3, fr = t_ & 15, ln = t_ & 63, fr2 = ln >> 2, fq2 = ln & 3;
        const int srcb = 4 * ((ln & 3) * 16 + (ln >> 2));
        const int row0 = u.pm * BM + wr * 64, col0 = u.pn * HALF + wc * 32 + 8 * fq2;
        unsigned long long sv[2][4];
#pragma unroll
        for (int ai = 0; ai < 2; ++ai)
#pragma unroll
            for (int m = 0; m < 4; ++m) sv[ai][m] = ss[row0 + fr + ai * HALF + m * 16];
#pragma unroll
        for (int ai = 0; ai < 2; ++ai)
#pragma unroll
            for (int m = 0; m < 4; ++m) { const float rs = __builtin_amdgcn_rsqf((float)sv[ai][m] * (1.0f / (2048.0f * 16777216.0f)) + 1e-6f);
                float o[8];
#pragma unroll
                for (int n = 0; n < 2; ++n)
#pragma unroll
                    for (int j = 0; j < 4; ++j) { const float g = acc[ai][0][m][n][j] * rs, up = acc[ai][1][m][n][j] * rs;
                        const float sg = g * __builtin_amdgcn_rcpf(1.0f + __builtin_amdgcn_exp2f(-1.4426950408889634f * g)); o[n * 4 + j] = sg * up; }
                u32x4 w = {cvt_pk_bf16(o[0], o[1]), cvt_pk_bf16(o[2], o[3]), cvt_pk_bf16(o[4], o[5]), cvt_pk_bf16(o[6], o[7])};
                *(u32x4*)(O + (size_t)(row0 + fr2 + ai * HALF + m * 16) * 5632 + col0) = lane_t416(w, srcb); }
    }
};
template <bool FINAL> struct EpiResT {
    static constexpr bool PERM = true, AFTER_DRAIN = false;
    float* Xout; bf16_t* XB; unsigned long long* ssn;
    __device__ __forceinline__ void operator()(const f32x4 (&acc)[2][2][4][2], const Unit& u, int, int, int, int) const {
        const int t_ = otid(), wid_ = t_ >> 6, wr = wid_ >> 2, wc = wid_ & 3, fr = t_ & 15, fq = (t_ >> 4) & 3, ln = t_ & 63, fr2 = ln >> 2, fq2 = ln & 3;
        const int srcb = 4 * ((ln & 3) * 16 + (ln >> 2));
        const int row0 = u.pm * BM + wr * 64 + fr, col0 = u.pn * BM + wc * 32 + 8 * fq;
        u32x4 xo[4][2], xn[4][2];
#define ER_LOAD(dst, ai) do { _Pragma("unroll") for (int m = 0; m < 4; ++m) { const bf16_t* br = XB + (size_t)(row0 + (ai) * HALF + m * 16) * 2048 + col0; \
            _Pragma("unroll") for (int bj = 0; bj < 2; ++bj) dst[m][bj] = *(const u32x4*)(br + bj * HALF); } } while (0)
        ER_LOAD(xo, 0);
#pragma unroll
        for (int ai = 0; ai < 2; ++ai) {
            if (ai == 0) ER_LOAD(xn, 1);
#pragma unroll
            for (int m = 0; m < 4; ++m) { const int row = row0 + ai * HALF + m * 16; float part = 0.f; bf16_t* br = XB + (size_t)row * 2048 + col0;
#pragma unroll
                for (int bj = 0; bj < 2; ++bj) { const u32x4 o = xo[m][bj];
                    f32x4 a = {__uint_as_float(o[0] << 16), __uint_as_float(o[0] & 0xffff0000u), __uint_as_float(o[1] << 16), __uint_as_float(o[1] & 0xffff0000u)};
                    f32x4 b = {__uint_as_float(o[2] << 16), __uint_as_float(o[2] & 0xffff0000u), __uint_as_float(o[3] << 16), __uint_as_float(o[3] & 0xffff0000u)};
                    a += acc[ai][bj][m][0]; b += acc[ai][bj][m][1];
                    if constexpr (FINAL) { float* xr = Xout + (size_t)row * 2048 + col0 + bj * HALF; *(f32x4*)xr = a; *(f32x4*)(xr + 4) = b; }
                    else { u32x4 w = {cvt_pk_bf16(a[0], a[1]), cvt_pk_bf16(a[2], a[3]), cvt_pk_bf16(b[0], b[1]), cvt_pk_bf16(b[2], b[3])};
                        *(u32x4*)(XB + (size_t)(row - fr + fr2) * 2048 + col0 - 8 * fq + 8 * fq2 + bj * HALF) = lane_t416(w, srcb);
                        part += a[0] * a[0] + a[1] * a[1] + a[2] * a[2] + a[3] * a[3] + b[0] * b[0] + b[1] * b[1] + b[2] * b[2] + b[3] * b[3]; } }
                if constexpr (!FINAL) { part += __shfl_xor(part, 16); part += __shfl_xor(part, 32);
                    if (fq == 0) atomicAdd(ssn + row, (unsigned long long)(part * 16777216.0f)); } }
            if (ai == 0) {
#pragma unroll
                for (int m = 0; m < 4; ++m)
#pragma unroll
                    for (int bj = 0; bj < 2; ++bj) xo[m][bj] = xn[m][bj]; }
        }
#undef ER_LOAD
    }
};
template <class Epi, class Sched, bool STAMP = false>
__device__ __forceinline__ void gemm_phase(PG8_LAS unsigned char* lds, const Gemm g, const Sched& S, const Epi& E, unsigned long long* stamps) {
    const int tid = otid(), wid = __builtin_amdgcn_readfirstlane(tid >> 6), lane = tid & 63, wr = wid >> 2, wc = wid & 3, fr = lane & 15, fq = lane >> 4;
    const int K = g.K, nt = K / BK;
    int ts_lo = 0, ts_hi = 0, nts = 0; const unsigned long long rt_entry = STAMP ? (unsigned long long)wall_clock64() : 0ull;
#define PG8_STAMP() do { if (STAMP && wid == 0 && nts < 64) { const unsigned long long _c = (unsigned long long)clock64(); \
        ts_lo = (lane == nts) ? (int)(unsigned)_c : ts_lo; ts_hi = (lane == nts) ? (int)(unsigned)(_c >> 32) : ts_hi; ++nts; } } while (0)
    PG8_STAMP();
    unsigned voffA[2], voffB[2];
#pragma unroll
    for (int i = 0; i < 2; ++i) { int R, C; stage_rc(tid * 16 + i * 8192, R, C); const int Rb = Epi::PERM ? ((R & ~31) + perm32(R & 31)) : R;
        voffA[i] = (unsigned)(R * K + C) * 2u; voffB[i] = (unsigned)(Rb * K + C) * 2u; }
    const size_t kstep = (size_t)(BK * 2);
    const size_t hstep = (size_t)HALF * K * 2;
    const size_t tstep = 2 * hstep;
    const unsigned ldsw = (unsigned)wid * 1024u;
    const int aoff = lds_byte(wr * 64 + fr, fq * 8), boff = lds_byte(wc * 32 + fr, fq * 8);
#define PG8_SA(b, h) (((b) * 2 + (h)) * HTB)
#define PG8_SB(b, h) ((4 + (b) * 2 + (h)) * HTB)
#define PG8_STAGE(bufoff, gbase, voff) do { _Pragma("unroll") for (int _i = 0; _i < 2; ++_i) \
        __builtin_amdgcn_global_load_lds((const unsigned*)((const char*)(gbase) + (voff)[_i]), (PG8_LAS unsigned*)(lds + (bufoff) + ldsw + _i * 8192), 16, 0, 0); } while (0)
#define PG8_LDA(dst, b, h) do { _Pragma("unroll") for (int m = 0; m < 4; ++m) _Pragma("unroll") for (int k = 0; k < 2; ++k) dst[m][k] = *(const PG8_LAS bf16x8*)(lds + PG8_SA(b, h) + aoff + m * 2048 + k * 1024); } while (0)
#define PG8_LDB(dst, b, h) do { _Pragma("unroll") for (int n = 0; n < 2; ++n) _Pragma("unroll") for (int k = 0; k < 2; ++k) dst[n][k] = *(const PG8_LAS bf16x8*)(lds + PG8_SB(b, h) + boff + n * 2048 + k * 1024); } while (0)
#define PG8_MMA(ai, bj, At, Bt) do { __builtin_amdgcn_s_setprio(1); _Pragma("unroll") for (int m = 0; m < 4; ++m) _Pragma("unroll") for (int n = 0; n < 2; ++n) _Pragma("unroll") for (int k = 0; k < 2; ++k) \
        acc[ai][bj][m][n] = __builtin_amdgcn_mfma_f32_16x16x32_bf16(Bt[n][k], At[m][k], acc[ai][bj][m][n], 0, 0, 0); __builtin_amdgcn_s_setprio(0); } while (0)
#define PG8_WAIT_V(n) asm volatile("s_waitcnt vmcnt(" #n ")" ::: "memory")
#define PG8_WAIT_L(n) asm volatile("s_waitcnt lgkmcnt(" #n ")" ::: "memory")
#define PG8_BAR __builtin_amdgcn_s_barrier()
#define PG8_SCHED __builtin_amdgcn_sched_barrier(0)
    Unit cur, nxt; int ui = 0;
    if (!S.next(0, cur)) return;
    f32x4 acc[2][2][4][2];
#pragma unroll
    for (int a = 0; a < 2; ++a)
#pragma unroll
        for (int b = 0; b < 2; ++b)
#pragma unroll
            for (int m = 0; m < 4; ++m)
#pragma unroll
                for (int n = 0; n < 2; ++n) acc[a][b][m][n] = (f32x4){0.f, 0.f, 0.f, 0.f};
    bf16x8 At[4][2], B0[2][2], B1[2][2];
    const char* cA = (const char*)g.A + (size_t)cur.pm * tstep; const char* cB = (const char*)g.Bt + (size_t)cur.pn * tstep;
    S.a_ready(cur);
    PG8_STAGE(PG8_SB(0, 0), cB, voffB); PG8_STAGE(PG8_SA(0, 0), cA, voffA); PG8_STAGE(PG8_SB(0, 1), cB + hstep, voffB); PG8_STAGE(PG8_SA(0, 1), cA + hstep, voffA);
    if (wr == 1) PG8_BAR;
    PG8_WAIT_V(4); PG8_BAR;
    PG8_STAGE(PG8_SB(1, 0), cB + kstep, voffB); PG8_STAGE(PG8_SA(1, 0), cA + kstep, voffA); PG8_STAGE(PG8_SB(1, 1), cB + hstep + kstep, voffB);
    PG8_WAIT_V(6); PG8_BAR;
    PG8_STAMP();
    for (;;) {
        const bool has_next = S.next(ui + 1, nxt);
        const char* nA = has_next ? (const char*)g.A + (size_t)nxt.pm * tstep : cA; const char* nB = has_next ? (const char*)g.Bt + (size_t)nxt.pn * tstep : cB;
        for (int t = 0; t < nt; t += 2) {
            const bool last = (t == nt - 2);
            const char* a1 = cA + (size_t)(t + 1) * kstep;
            const char* a2 = last ? nA : cA + (size_t)(t + 2) * kstep; const char* b2 = last ? nB : cB + (size_t)(t + 2) * kstep;
            const char* a3 = a2 + kstep; const char* b3 = b2 + kstep;
            if (last && has_next) S.a_ready(nxt);
            PG8_LDB(B0, 0, 0); PG8_SCHED; PG8_LDA(At, 0, 0); PG8_STAGE(PG8_SA(1, 1), a1 + hstep, voffA);
            PG8_WAIT_L(8); PG8_BAR; PG8_WAIT_L(0); PG8_MMA(0, 0, At, B0); PG8_BAR; PG8_SCHED;
            PG8_LDB(B1, 0, 1); PG8_STAGE(PG8_SB(0, 0), b2, voffB);
            PG8_BAR; PG8_WAIT_L(0); PG8_MMA(0, 1, At, B1); PG8_BAR;
            PG8_LDA(At, 0, 1); PG8_STAGE(PG8_SA(0, 0), a2, voffA);
            PG8_BAR; PG8_WAIT_L(0); PG8_MMA(1, 0, At, B0); PG8_BAR; PG8_SCHED;
            PG8_STAGE(PG8_SB(0, 1), b2 + hstep, voffB);
            PG8_WAIT_V(6); PG8_BAR; PG8_MMA(1, 1, At, B1); PG8_BAR;
            PG8_LDB(B0, 1, 0); PG8_SCHED; PG8_LDA(At, 1, 0); PG8_STAGE(PG8_SA(0, 1), a2 + hstep, voffA);
            PG8_WAIT_L(8); PG8_BAR; PG8_WAIT_L(0); PG8_MMA(0, 0, At, B0); PG8_BAR; PG8_SCHED;
            PG8_LDB(B1, 1, 1); PG8_STAGE(PG8_SB(1, 0), b3, voffB);
            PG8_BAR; PG8_WAIT_L(0); PG8_MMA(0, 1, At, B1); PG8_BAR;
            PG8_LDA(At, 1, 1); PG8_STAGE(PG8_SA(1, 0), a3, voffA);
            PG8_BAR; PG8_WAIT_L(0); PG8_MMA(1, 0, At, B0); PG8_BAR; PG8_SCHED;
            PG8_STAGE(PG8_SB(1, 1), b3 + hstep, voffB);
            PG8_WAIT_V(6); PG8_BAR; PG8_MMA(1, 1, At, B1); PG8_BAR;
        }
        PG8_STAMP();
        if constexpr (!Epi::AFTER_DRAIN) { E(acc, cur, wr, wc, fr, fq); S.done(cur); }
        PG8_STAMP();
        if (!has_next) break;
#pragma unroll
        for (int a = 0; a < 2; ++a)
#pragma unroll
            for (int b = 0; b < 2; ++b)
#pragma unroll
                for (int m = 0; m < 4; ++m)
#pragma unroll
                    for (int n = 0; n < 2; ++n) acc[a][b][m][n] = (f32x4){0.f, 0.f, 0.f, 0.f};
        cur = nxt; cA = nA; cB = nB; ++ui;
    }
    PG8_WAIT_V(0);
    if (wr == 0) PG8_BAR;
    PG8_BAR;
    if constexpr (Epi::AFTER_DRAIN) { E.fused(acc, cur, wr, wc, fr, fq, lds, wid, lane); S.done(cur); }
    PG8_STAMP();
    if (STAMP && wid == 0) { stamps[lane] = lane < nts ? (((unsigned long long)(unsigned)ts_hi << 32) | (unsigned)ts_lo) : 0ull;
        if (lane == 62) stamps[62] = rt_entry; if (lane == 63) stamps[63] = (unsigned long long)wall_clock64(); }
#undef PG8_STAMP
#undef PG8_SA
#undef PG8_SB
#undef PG8_STAGE
#undef PG8_LDA
#undef PG8_LDB
#undef PG8_MMA
#undef PG8_WAIT_V
#undef PG8_WAIT_L
#undef PG8_BAR
#undef PG8_SCHED
}
}

namespace at {
using bf16 = __hip_bfloat16;
constexpr int D = 128, NW = 8, QBLK = 32, KVBLK = 64;
constexpr float SCALE = 0.088388347648318440f;
constexpr float THR = 8.f;
constexpr size_t SHM_V = KVBLK * D * 2, SHM_K = KVBLK * D * 2, SHM_ATTN = 2 * SHM_V + 2 * SHM_K + NW * 64 * 4;
using bf16x8 = __attribute__((ext_vector_type(8))) short;
using s16x4  = __attribute__((ext_vector_type(4))) short;
using f32x16 = __attribute__((ext_vector_type(16))) float;
using u32x4  = __attribute__((ext_vector_type(4))) unsigned;
#define KSWZ(row, colB) ((row) * 256 + ((colB) ^ (((row) & 7) << 4)))
#define SBAR() __builtin_amdgcn_sched_barrier(0)
__device__ __forceinline__ int crow(int r, int hi) { return (r & 3) + 8 * (r >> 2) + 4 * hi; }
__device__ __forceinline__ unsigned cvtpk(float lo, float hi) {
  unsigned r; asm volatile("v_cvt_pk_bf16_f32 %0, %1, %2" : "=v"(r) : "v"(lo), "v"(hi)); return r;
}
struct PolNone { __device__ __forceinline__ void apply(f32x16&, f32x16&, int, int) const {} __device__ __forceinline__ bool live(int) const { return true; } };
struct PolWin {
  int qp, kb0, W, qw0;
  __device__ __forceinline__ bool live(int t) const { const int k0 = kb0 + 64 * t; return __builtin_amdgcn_readfirstlane((k0 <= qw0 + 31 + W) && (k0 + 63 >= qw0 - W)) != 0; }
  __device__ __forceinline__ void apply(f32x16& p0, f32x16& p1, int t, int hi) const {
    const int base = kb0 + 64 * t - qp + 4 * hi + W; const unsigned lim = 2u * (unsigned)W;
#pragma unroll
    for (int r = 0; r < 16; ++r) { const int d0 = base + (r & 3) + 8 * (r >> 2);
      p0[r] = ((unsigned)d0 > lim) ? -INFINITY : p0[r]; p1[r] = ((unsigned)(d0 + 32) > lim) ? -INFINITY : p1[r]; }
  }
};
struct PolNA {
  int r, c, rstart; const float* rpb;
  __device__ __forceinline__ bool live(int t) const { const int rho = rstart + t, r0 = min(max(r - 4, 0), 56); return __builtin_amdgcn_readfirstlane((rho >= r0) && (rho < r0 + 8)) != 0; }
  __device__ __forceinline__ void apply(f32x16& p0, f32x16& p1, int t, int hi) const {
    const int rho = rstart + t; const int r0 = min(max(r - 4, 0), 56), c0 = min(max(c - 8, 0), 48);
    const bool rv = (rho >= r0) && (rho < r0 + 8);
    const int bbase = rv ? (rho - r + 7) * 31 + 15 - c : 15 - c;
    constexpr float ISC = 11.313708498984761f;
#pragma unroll
    for (int rr = 0; rr < 16; ++rr) { const int k0 = (rr & 3) + 8 * (rr >> 2) + 4 * hi, k1 = k0 + 32;
      const bool v0 = rv && ((unsigned)(k0 - c0) < 16u), v1 = rv && ((unsigned)(k1 - c0) < 16u);
      const float b0 = rpb[v0 ? bbase + k0 : 0], b1 = rpb[v1 ? bbase + k1 : 0];
      p0[rr] = v0 ? fmaf(b0, ISC, p0[rr]) : -INFINITY; p1[rr] = v1 ? fmaf(b1, ISC, p1[rr]) : -INFINITY; }
  }
};
template <class Pol>
__device__ __forceinline__ void partialSM(f32x16& p0, f32x16& p1, float& m_reg, float& mn, float& alpha, const Pol& pol, int tile, int hi) {
  constexpr float C = SCALE * 1.4426950408889634f;
  pol.apply(p0, p1, tile, hi);
  float pmax = p0[0];
#pragma unroll
  for (int r = 1; r < 16; ++r) pmax = fmaxf(pmax, p0[r]);
#pragma unroll
  for (int r = 0; r < 16; ++r) pmax = fmaxf(pmax, p1[r]);
  { auto rr = __builtin_amdgcn_permlane32_swap(__float_as_uint(pmax), __float_as_uint(pmax), false, false);
    pmax = fmaxf(__uint_as_float(rr[0]), __uint_as_float(rr[1])); }
  if (__builtin_expect(__all(pmax - m_reg <= THR / SCALE), 1)) { mn = m_reg; alpha = 1.f; }
  else { mn = fmaxf(m_reg, pmax); alpha = __builtin_amdgcn_exp2f((m_reg - mn) * C); m_reg = mn; }
  float mnC = -mn * C;
#pragma unroll
  for (int r = 0; r < 16; ++r) p0[r] = fmaf(p0[r], C, mnC);
#pragma unroll
  for (int r = 0; r < 16; ++r) p1[r] = fmaf(p1[r], C, mnC);
#pragma unroll
  for (int r = 0; r < 16; ++r) p0[r] = __builtin_amdgcn_exp2f(p0[r]);
}
__device__ __forceinline__ void finishSM(f32x16& p0, f32x16& p1, float alpha, float& l_reg, bf16x8& pa0, bf16x8& pa1, bf16x8& pa2, bf16x8& pa3) {
#pragma unroll
  for (int r = 0; r < 16; ++r) p1[r] = __builtin_amdgcn_exp2f(p1[r]);
  float ps = 0;
#pragma unroll
  for (int r = 0; r < 16; ++r) ps += p0[r];
#pragma unroll
  for (int r = 0; r < 16; ++r) ps += p1[r];
  { auto rr = __builtin_amdgcn_permlane32_swap(__float_as_uint(ps), __float_as_uint(ps), false, false);
    ps = __uint_as_float(rr[0]) + __uint_as_float(rr[1]); }
  l_reg = l_reg * alpha + ps;
#define PK4(P, BASE, OUT) do { unsigned a0 = cvtpk(P[BASE + 0], P[BASE + 1]), a1 = cvtpk(P[BASE + 2], P[BASE + 3]);   \
    unsigned b0 = cvtpk(P[BASE + 4], P[BASE + 5]), b1 = cvtpk(P[BASE + 6], P[BASE + 7]);                              \
    auto r0 = __builtin_amdgcn_permlane32_swap(a0, b0, false, false); auto r1 = __builtin_amdgcn_permlane32_swap(a1, b1, false, false); \
    u32x4 w = {r0[0], r1[0], r0[1], r1[1]}; OUT = *reinterpret_cast<bf16x8*>(&w); } while (0)
  PK4(p0, 0, pa0); PK4(p0, 8, pa1); PK4(p1, 0, pa2); PK4(p1, 8, pa3);
#undef PK4
}
__device__ __forceinline__ void qkt(f32x16& p0, f32x16& p1, const bf16* Ks, const bf16x8* qr, int r32, int hi) {
  p0 = f32x16{}; p1 = f32x16{};
#pragma unroll
  for (int d0 = 0; d0 < 8; ++d0) { int cb = (d0 * 16 + hi * 8) * 2;
    bf16x8 b0 = *reinterpret_cast<const bf16x8*>((const char*)Ks + KSWZ(r32, cb));
    bf16x8 b1 = *reinterpret_cast<const bf16x8*>((const char*)Ks + KSWZ(32 + r32, cb));
    p0 = __builtin_amdgcn_mfma_f32_32x32x16_bf16(b0, qr[d0], p0, 0, 0, 0);
    p1 = __builtin_amdgcn_mfma_f32_32x32x16_bf16(b1, qr[d0], p1, 0, 0, 0); }
}
__device__ __forceinline__ int v_st(int k, int c) { const int kk = (k & ~0xC) | ((k & 4) << 1) | ((k & 8) >> 1); return ((kk >> 3) * 4 + (c >> 5)) * 512 + ((kk & 7) * 32 + (c & 31)) * 2; }
__device__ __forceinline__ int v_rd_base(int lane) { return ((lane & 3) << 3) | (((lane >> 2) & 3) << 6) | (((lane >> 4) & 1) << 5) | (((lane >> 5) & 1) << 8); }
constexpr int v_rd_off(int d0, int ks, int half) { return d0 * 512 + ks * 4096 + half * 2048; }
template <int OFF> __device__ __forceinline__ s16x4 tr_read(int vb) {
  s16x4 r; asm volatile("ds_read_b64_tr_b16 %0, %1 offset:%2" : "=&v"(r) : "v"(vb), "i"(OFF) : "memory"); return r;
}
template <int D0> __device__ __forceinline__ void pv_one(f32x16& od, int vb, bf16x8 pa0, bf16x8 pa1, bf16x8 pa2, bf16x8 pa3) {
  const s16x4 l0 = tr_read<v_rd_off(D0, 0, 0)>(vb), h0 = tr_read<v_rd_off(D0, 0, 1)>(vb), l1 = tr_read<v_rd_off(D0, 1, 0)>(vb), h1 = tr_read<v_rd_off(D0, 1, 1)>(vb);
  const s16x4 l2 = tr_read<v_rd_off(D0, 2, 0)>(vb), h2 = tr_read<v_rd_off(D0, 2, 1)>(vb), l3 = tr_read<v_rd_off(D0, 3, 0)>(vb), h3 = tr_read<v_rd_off(D0, 3, 1)>(vb);
  asm volatile("s_waitcnt lgkmcnt(0)" ::: "memory"); SBAR();
#define PK(L, H) (bf16x8){L[0], L[1], L[2], L[3], H[0], H[1], H[2], H[3]}
  od = __builtin_amdgcn_mfma_f32_32x32x16_bf16(pa0, PK(l0, h0), od, 0, 0, 0);
  od = __builtin_amdgcn_mfma_f32_32x32x16_bf16(pa1, PK(l1, h1), od, 0, 0, 0);
  od = __builtin_amdgcn_mfma_f32_32x32x16_bf16(pa2, PK(l2, h2), od, 0, 0, 0);
  od = __builtin_amdgcn_mfma_f32_32x32x16_bf16(pa3, PK(l3, h3), od, 0, 0, 0);
#undef PK
}
__device__ __forceinline__ void pv_d0(f32x16* o, int vb, bf16x8 pa0, bf16x8 pa1, bf16x8 pa2, bf16x8 pa3) {
  pv_one<0>(o[0], vb, pa0, pa1, pa2, pa3); pv_one<1>(o[1], vb, pa0, pa1, pa2, pa3); pv_one<2>(o[2], vb, pa0, pa1, pa2, pa3); pv_one<3>(o[3], vb, pa0, pa1, pa2, pa3);
}

template <class Pol, int ldq, int ldk, int ldo>
__device__ __forceinline__ void attn_body(const bf16* __restrict__ Qb, const bf16* __restrict__ Kh, const bf16* __restrict__ Vh,
                                          unsigned short* __restrict__ Ob, int NT, char* lds, const Pol& pol) {
  const float sink_l2 = -INFINITY; float* const ml = nullptr; const long ldml = 0;
  const int tid = otid(), wid = tid >> 6, lane = tid & 63, r32 = lane & 31, hi = lane >> 5;
  bf16* V_lds = (bf16*)lds; bf16* K_lds = (bf16*)(lds + 2 * SHM_V);
  float* ws = (float*)(lds + 2 * SHM_V + 2 * SHM_K) + wid * 64; float* li_l = ws; float* al_l = ws + 32;
  float m_reg = -1e30f, l_reg = 0; f32x16 o[4] = {}; bf16x8 qr[8];
  const bf16* Qw = Qb + (long)(wid * QBLK + r32) * ldq + hi * 8;
#pragma unroll
  for (int d0 = 0; d0 < 8; ++d0) qr[d0] = *reinterpret_cast<const bf16x8*>(Qw + d0 * 16);
  const int sr = tid >> 4, sc = (tid & 15) * 8, vst0 = v_st(sr, sc), vst1 = v_st(32 + sr, sc);
  const int vb0 = (int)(uintptr_t)V_lds + v_rd_base(lane);
  struct { bf16x8 vs0, vs1, ks0, ks1; } sr_[2];
#define SLOAD(i, k0) do { sr_[i].vs0 = *reinterpret_cast<const bf16x8*>(&Vh[(long)((k0) + sr) * ldk + sc]); sr_[i].vs1 = *reinterpret_cast<const bf16x8*>(&Vh[(long)((k0) + 32 + sr) * ldk + sc]); \
    sr_[i].ks0 = *reinterpret_cast<const bf16x8*>(&Kh[(long)((k0) + sr) * ldk + sc]); sr_[i].ks1 = *reinterpret_cast<const bf16x8*>(&Kh[(long)((k0) + 32 + sr) * ldk + sc]); } while (0)
#define SWRITE(b, i) do { *(bf16x8*)((char*)V_lds + (b) * SHM_V + vst0) = sr_[i].vs0;          \
    *(bf16x8*)((char*)V_lds + (b) * SHM_V + vst1) = sr_[i].vs1; int kc = sc * 2;               \
    *(bf16x8*)((char*)K_lds + (b) * SHM_K + KSWZ(sr, kc)) = sr_[i].ks0;                       \
    *(bf16x8*)((char*)K_lds + (b) * SHM_K + KSWZ(32 + sr, kc)) = sr_[i].ks1; } while (0)
#define SWAIT() asm volatile("s_waitcnt vmcnt(4)" ::: "memory")
#define RESC(a) do { if (__any((a) < 1.f)) { if (hi == 0) al_l[r32] = (a); asm volatile("s_waitcnt lgkmcnt(0)" ::: "memory"); \
    _Pragma("unroll") for (int d = 0; d < 4; ++d) _Pragma("unroll") for (int r = 0; r < 16; ++r) o[d][r] *= al_l[crow(r, hi)]; } } while (0)
  f32x16 pA0, pA1, pB0, pB1; float mnA, mnB, alA, alB; bf16x8 pa0, pa1, pa2, pa3;
  constexpr int SE = 0, SO = 1;
  SLOAD(SE, 0); asm volatile("s_waitcnt vmcnt(0)" ::: "memory"); SWRITE(0, SE); __syncthreads();
  qkt(pA0, pA1, K_lds, qr, r32, hi); partialSM(pA0, pA1, m_reg, mnA, alA, pol, 0, hi);
  SLOAD(SO, KVBLK); if (2 < NT) SLOAD(SE, 2 * KVBLK);
  SWAIT(); SWRITE(1, SO); __syncthreads();
  for (int j = 1; j + 1 < NT; j += 2) {
    SBAR(); qkt(pB0, pB1, (bf16*)((char*)K_lds + SHM_K), qr, r32, hi);
    finishSM(pA0, pA1, alA, l_reg, pa0, pa1, pa2, pa3); SBAR();
    SLOAD(SO, (j + 2) * KVBLK); SBAR();
    pv_d0(o, vb0, pa0, pa1, pa2, pa3); partialSM(pB0, pB1, m_reg, mnB, alB, pol, j, hi);
    __syncthreads(); SWAIT(); SWRITE(0, SE);
    RESC(alB); __syncthreads();
    SBAR(); qkt(pA0, pA1, K_lds, qr, r32, hi);
    finishSM(pB0, pB1, alB, l_reg, pa0, pa1, pa2, pa3); SBAR();
    if (j + 3 < NT) SLOAD(SE, (j + 3) * KVBLK); SBAR();
    pv_d0(o, vb0 + (int)SHM_V, pa0, pa1, pa2, pa3); partialSM(pA0, pA1, m_reg, mnA, alA, pol, j + 1, hi);
    __syncthreads(); SWAIT(); SWRITE(1, SO);
    RESC(alA); __syncthreads();
  }
  SBAR(); qkt(pB0, pB1, (bf16*)((char*)K_lds + SHM_K), qr, r32, hi);
  finishSM(pA0, pA1, alA, l_reg, pa0, pa1, pa2, pa3); SBAR();
  pv_d0(o, vb0, pa0, pa1, pa2, pa3); partialSM(pB0, pB1, m_reg, mnB, alB, pol, NT - 1, hi);
  __syncthreads(); RESC(alB);
  finishSM(pB0, pB1, alB, l_reg, pa0, pa1, pa2, pa3); SBAR();
  pv_d0(o, vb0 + (int)SHM_V, pa0, pa1, pa2, pa3);
  constexpr float C = SCALE * 1.4426950408889634f;
  if (ml != nullptr && hi == 0) { float* mp = ml + (long)(wid * QBLK + r32) * ldml; mp[0] = m_reg * C; mp[1] = l_reg; }
  l_reg += __builtin_amdgcn_exp2f(sink_l2 - m_reg * C);
  if (hi == 0) li_l[r32] = l_reg; asm volatile("s_waitcnt lgkmcnt(0)" ::: "memory");
  float rli[16];
#pragma unroll
  for (int r = 0; r < 16; ++r) rli[r] = __builtin_amdgcn_rcpf(li_l[crow(r, hi)]);
  unsigned short* Ow = Ob + (long)(wid * QBLK) * ldo;
#pragma unroll
  for (int r = 0; r < 16; ++r) { int orow = crow(r, hi);
#pragma unroll
    for (int d0 = 0; d0 < 4; ++d0) { const float v = o[d0][r] * rli[r]; Ow[(long)orow * ldo + d0 * 32 + r32] = (unsigned short)(cvtpk(v, v) & 0xffffu); } }
#undef SLOAD
#undef SWRITE
#undef SWAIT
#undef RESC
}
template <class Pol>
__device__ __forceinline__ void attn_body_simple(const bf16* __restrict__ Qb, long ldq, const bf16* __restrict__ Kh, const bf16* __restrict__ Vh, long ldk,
                                                 unsigned short* __restrict__ Ob, long ldo, int NT, char* lds, const Pol& pol, float sink_l2, float* ml, long ldml) {
  const int tid = otid(), wid = tid >> 6, lane = tid & 63, r32 = lane & 31, hi = lane >> 5;
  bf16* V_lds = (bf16*)lds; bf16* K_lds = (bf16*)(lds + 2 * SHM_V);
  float* ws = (float*)(lds + 2 * SHM_V + 2 * SHM_K) + wid * 64; float* li_l = ws; float* al_l = ws + 32;
  float m_reg = -1e30f, l_reg = 0; f32x16 o[4] = {}; bf16x8 qr[8];
  const bf16* Qw = Qb + (long)(wid * QBLK + r32) * ldq + hi * 8;
#pragma unroll
  for (int d0 = 0; d0 < 8; ++d0) qr[d0] = *reinterpret_cast<const bf16x8*>(Qw + d0 * 16);
  const int sr = tid >> 4, sc = (tid & 15) * 8, vst0 = v_st(sr, sc), vst1 = v_st(32 + sr, sc);
  const int vb0 = (int)(uintptr_t)V_lds + v_rd_base(lane);
  const bf16* kp = Kh + (long)sr * ldk + sc; const bf16* vp = Vh + (long)sr * ldk + sc; const long step32 = 32 * ldk, step64 = 64 * ldk;
  struct { bf16x8 vs0, vs1, ks0, ks1; } sg[2];
#define LOADT(i) do { sg[i].vs0 = *reinterpret_cast<const bf16x8*>(vp); sg[i].vs1 = *reinterpret_cast<const bf16x8*>(vp + step32); \
    sg[i].ks0 = *reinterpret_cast<const bf16x8*>(kp); sg[i].ks1 = *reinterpret_cast<const bf16x8*>(kp + step32); kp += step64; vp += step64; } while (0)
#define WRITET(b, i) do { *(bf16x8*)((char*)V_lds + (b) * SHM_V + vst0) = sg[i].vs0; *(bf16x8*)((char*)V_lds + (b) * SHM_V + vst1) = sg[i].vs1; int kc = sc * 2; \
    *(bf16x8*)((char*)K_lds + (b) * SHM_K + KSWZ(sr, kc)) = sg[i].ks0; *(bf16x8*)((char*)K_lds + (b) * SHM_K + KSWZ(32 + sr, kc)) = sg[i].ks1; } while (0)
#define RESC(a) do { if (__any((a) < 1.f)) { if (hi == 0) al_l[r32] = (a); asm volatile("s_waitcnt lgkmcnt(0)" ::: "memory"); \
    _Pragma("unroll") for (int d = 0; d < 4; ++d) _Pragma("unroll") for (int r = 0; r < 16; ++r) o[d][r] *= al_l[crow(r, hi)]; } } while (0)
#define TILE(t, b) do { if (pol.live(t)) { f32x16 p0, p1; float mn, al; bf16x8 pa0, pa1, pa2, pa3; \
      qkt(p0, p1, (const bf16*)((const char*)K_lds + (b) * SHM_K), qr, r32, hi); partialSM(p0, p1, m_reg, mn, al, pol, t, hi); RESC(al); \
      finishSM(p0, p1, al, l_reg, pa0, pa1, pa2, pa3); SBAR(); pv_d0(o, vb0 + (b) * (int)SHM_V, pa0, pa1, pa2, pa3); } } while (0)
  LOADT(0); WRITET(0, 0); LOADT(1);
  for (int t = 0; t < NT; t += 2) {
    __syncthreads();
    if (t + 2 < NT) LOADT(0);
    TILE(t, 0);
    WRITET(1, 1);
    __syncthreads();
    if (t + 3 < NT) LOADT(1);
    TILE(t + 1, 1);
    if (t + 2 < NT) WRITET(0, 0);
  }
#undef TILE
  constexpr float C = SCALE * 1.4426950408889634f;
  if (ml != nullptr && hi == 0) { float* mp = ml + (long)(wid * QBLK + r32) * ldml; mp[0] = m_reg * C; mp[1] = l_reg; }
  l_reg += __builtin_amdgcn_exp2f(sink_l2 - m_reg * C);
  if (hi == 0) li_l[r32] = l_reg; asm volatile("s_waitcnt lgkmcnt(0)" ::: "memory");
  float rli[16];
#pragma unroll
  for (int r = 0; r < 16; ++r) rli[r] = __builtin_amdgcn_rcpf(li_l[crow(r, hi)]);
  unsigned short* Ow = Ob + (long)(wid * QBLK) * ldo;
#pragma unroll
  for (int r = 0; r < 16; ++r) { int orow = crow(r, hi);
#pragma unroll
    for (int d0 = 0; d0 < 4; ++d0) { const float v = o[d0][r] * rli[r]; Ow[(long)orow * ldo + d0 * 32 + r32] = (unsigned short)(cvtpk(v, v) & 0xffffu); } }
#undef LOADT
#undef WRITET
#undef RESC
}
}

#define XB_TMO      128
#define XB_XCNT(j)  (256  + 64 * (j))
#define XB_XSUB(j)  (1280 + 64 * (j))
#define XB_XGEN(j)  (2304 + 64 * (j))
#define XB_TOP      3328
#define XB_TOPGEN   3392
#define XCD_BAR_WORDS 3456
#define XB_SPIN_CAP (1u << 18)
#define LAS __attribute__((address_space(3)))

__device__ __forceinline__ unsigned xb_ld(unsigned* p)              { return __hip_atomic_load(p, __ATOMIC_RELAXED, __HIP_MEMORY_SCOPE_AGENT); }
__device__ __forceinline__ unsigned xb_add(unsigned* p, unsigned v) { return __hip_atomic_fetch_add(p, v, __ATOMIC_RELAXED, __HIP_MEMORY_SCOPE_AGENT); }
__device__ __forceinline__ unsigned xb_xcc_id() { return (unsigned)__builtin_amdgcn_s_getreg((3 << 11) | 20) & 0xFu; }
#define XB_SPIN(cond, bar) do { unsigned _sp = 0; while (cond) { __builtin_amdgcn_s_sleep(1); \
    if ((++_sp & 255u) == 0u) { if (xb_ld(&(bar)[XB_TMO])) break; if (_sp > XB_SPIN_CAP) { atomicAdd(&(bar)[XB_TMO], 1u); break; } } } } while (0)

struct XcdBarrier {
    unsigned* bar; unsigned x;
    volatile LAS unsigned* st;
};

__device__ __forceinline__ XcdBarrier xcd_barrier_post(unsigned* bar, volatile LAS unsigned* st) {
    XcdBarrier b; b.bar = bar; b.x = xb_xcc_id(); b.st = st;
    if (threadIdx.x == 0) (void)xb_add(&bar[XB_XCNT(b.x)], 1u);
    return b;
}
__device__ __forceinline__ void xcd_barrier_complete(unsigned* bar, unsigned x, unsigned& nloc, unsigned& nx) {
    const unsigned G = gridDim.x * gridDim.y * gridDim.z;
    unsigned sum, cnt, mine, sp = 0u;
    for (;;) {
        sum = 0u; cnt = 0u; mine = 0u;
#pragma unroll
        for (unsigned j = 0; j < 16; ++j) { const unsigned c = xb_ld(&bar[XB_XCNT(j)]); sum += c; cnt += (c > 0u) ? 1u : 0u; mine = (j == x) ? c : mine; }
        if (sum == G) break;
        __builtin_amdgcn_s_sleep(1);
        if ((++sp & 255u) == 0u) { if (xb_ld(&bar[XB_TMO])) break; if (sp > XB_SPIN_CAP) { atomicAdd(&bar[XB_TMO], 1u); break; } }
    }
    nloc = mine > 0u ? mine : 1u; nx = cnt > 0u ? cnt : 1u;
}

__device__ __forceinline__ void xcd_barrier(const XcdBarrier& b) {
    asm volatile("s_waitcnt vmcnt(0)" ::: "memory");
    __syncthreads();
    if (threadIdx.x == 0) {
        unsigned* bar = b.bar; asm volatile("" : "+s"(bar)); unsigned bx = b.x; asm volatile("" : "+s"(bx));
        __builtin_amdgcn_s_waitcnt(0);
        unsigned nloc = b.st[0], nx = b.st[1];
        if (nloc == 0u) { xcd_barrier_complete(bar, bx, nloc, nx); b.st[0] = nloc; b.st[1] = nx; }
        const unsigned old = xb_add(&bar[XB_XSUB(bx)], 1u);
        const unsigned gen = old / nloc;
        if (old + 1u == (gen + 1u) * nloc) {
            __builtin_amdgcn_fence(__ATOMIC_RELEASE, "agent");
            asm volatile("s_waitcnt vmcnt(0)" ::: "memory");
            const unsigned og = xb_add(&bar[XB_TOP], 1u);
            const unsigned tg = og / nx;
            if (og + 1u == (tg + 1u) * nx) xb_add(&bar[XB_TOPGEN], 1u);
            else XB_SPIN(xb_ld(&bar[XB_TOPGEN]) == tg, bar);
            __builtin_amdgcn_fence(__ATOMIC_ACQUIRE, "agent");
            xb_add(&bar[XB_XGEN(bx)], 1u);
            asm volatile("s_waitcnt vmcnt(0)" ::: "memory");
        } else {
            XB_SPIN(xb_ld(&bar[XB_XGEN(bx)]) == gen, bar);
            __builtin_amdgcn_fence(__ATOMIC_ACQUIRE, "agent");
            asm volatile("s_waitcnt vmcnt(0)" ::: "memory");
        }
    }
    __syncthreads();
}

typedef unsigned short u16;
typedef unsigned u32x4_t __attribute__((ext_vector_type(4)));
constexpr int LDS_BYTES = 131072 + 4096 + 8192;
__device__ __forceinline__ float bf2f(unsigned short v) { return __uint_as_float((unsigned)v << 16); }
__device__ __forceinline__ unsigned pk2(float a, float b) { return pg8::cvt_pk_bf16(a, b); }

typedef float f4v __attribute__((ext_vector_type(4)));
struct ConvDesc { const float* src; const float* gain; u16* dst; int K, N, mode, k0, n0; };
__device__ __forceinline__ int conv_ntiles(int L) { return 32 * (((L & 1) ? CD_IN : AB_IN) / 256) + 256 + 3 * 704; }
__device__ __forceinline__ ConvDesc conv_desc(const Params& p, int L, int t) {
  const int j = L >> 1; const bool odd = L & 1; const int nin = odd ? CD_IN : AB_IN; const int t_in = 32 * (nin / 256); ConvDesc d;
  if (t < t_in) { d.src = odd ? p.cd_w_in + (size_t)j * DM * CD_IN : p.ab_w_in + (size_t)j * DM * AB_IN; d.gain = p.attn_norm + L * DM; d.dst = p.wt_in() + L * WT_IN_L; d.K = DM; d.N = nin; d.mode = odd ? 4 : 3; }
  else if ((t -= t_in) < 256) { d.src = odd ? p.cd_w_out + (size_t)j * DM * DM : p.ab_w_out + (size_t)j * DM * DM; d.gain = nullptr; d.dst = p.wt_out() + L * WT_OUT_L; d.K = DM; d.N = DM; d.mode = 0; }
  else if ((t -= 256) < 704) { d.src = p.w_gate + (size_t)L * DM * FFN; d.gain = p.ffn_norm + L * DM; d.dst = p.wt_gu() + L * WT_GU_L; d.K = DM; d.N = FFN; d.mode = 1; }
  else if ((t -= 704) < 704) { d.src = p.w_up + (size_t)L * DM * FFN; d.gain = p.ffn_norm + L * DM; d.dst = p.wt_gu() + L * WT_GU_L; d.K = DM; d.N = FFN; d.mode = 2; }
  else { t -= 704; d.src = p.w_down + (size_t)L * FFN * DM; d.gain = nullptr; d.dst = p.wt_dn() + L * WT_DN_L; d.K = FFN; d.N = DM; d.mode = 0; }
  const int ntn = d.N / 256, kt = t / ntn, nt = t - kt * ntn; d.k0 = kt * 64; d.n0 = nt * 256; return d;
}
__device__ __forceinline__ void conv_load(const ConvDesc& d, f4v (&v)[4][2], float& g0, float& g1, int tid) {
  const int rp = tid >> 4, cc = (tid & 15) * 4;
#pragma unroll
  for (int sub = 0; sub < 4; ++sub)
#pragma unroll
    for (int i = 0; i < 2; ++i) v[sub][i] = __builtin_nontemporal_load((const f4v*)(d.src + (size_t)(d.k0 + 2 * rp + i) * d.N + d.n0 + sub * 64 + cc));
  g0 = d.gain ? d.gain[d.k0 + 2 * rp] : 1.0f; g1 = d.gain ? d.gain[d.k0 + 2 * rp + 1] : 1.0f;
}
__device__ __forceinline__ void conv_stage(const f4v (&v)[4][2], float g0, float g1, char* shm, int tid) {
  unsigned* tile = (unsigned*)shm;
  const int rp = tid >> 4, cc = (tid & 15) * 4;
#pragma unroll
  for (int sub = 0; sub < 4; ++sub) { unsigned* tp = tile + sub * (32 * 65) + rp * 65 + cc;
#pragma unroll
    for (int e = 0; e < 4; ++e) tp[e] = pk2(v[sub][0][e] * g0, v[sub][1][e] * g1); }
}
__device__ __forceinline__ void conv_store(const ConvDesc& d, char* shm, int tid) {
  const unsigned* tile = (const unsigned*)shm; const int n = tid >> 3, kq = tid & 7;
#pragma unroll
  for (int sub = 0; sub < 4; ++sub) { u32x4_t w;
#pragma unroll
    for (int j = 0; j < 4; ++j) w[j] = tile[sub * (32 * 65) + (4 * kq + j) * 65 + n];
    const int cg = d.n0 + sub * 64 + n; int drow;
    if (d.mode == 0) drow = cg; else if (d.mode <= 2) drow = 256 * (cg >> 7) + (cg & 127) + (d.mode == 2 ? 128 : 0);
    else { const int head = cg >> 7, dd_ = cg & 127; int s_ = dd_;
      if (d.mode == 3) { if (head >= 24 && head < 34) { const int dd = dd_ & 63; s_ = 2 * ((dd & 31) + (dd_ >= 64 ? 32 : 0)) + (dd >> 5); } }
      else { if ((head < 16 || (head >= 20 && head < 36)) && dd_ < 32) s_ = 2 * (dd_ & 15) + (dd_ >> 4); }
      drow = head * 128 + s_; }
    *(u32x4_t*)(d.dst + (size_t)drow * d.K + d.k0 + 8 * kq) = w; }
}
__device__ __forceinline__ void conv_range(const Params& p, int L, int first, int hi, int step, char* shm) {
  int t = first; if (t >= hi) return;
  const int tid = otid(); f4v v[4][2]; float g0, g1;
  ConvDesc d = conv_desc(p, L, t); conv_load(d, v, g0, g1, tid);
  for (;;) {
    conv_stage(v, g0, g1, shm, tid); __syncthreads();
    const int tn = t + step; const bool more = tn < hi; ConvDesc dn = d;
    if (more) { dn = conv_desc(p, L, tn); conv_load(dn, v, g0, g1, tid); }
    conv_store(d, shm, tid); __syncthreads();
    if (!more) break;
    d = dn; t = tn;
  }
}
__device__ __forceinline__ int idle_first(int nwg, int G) { return nwg - ((nwg + G - 1) / G - 1) * G; }
__device__ __forceinline__ void conv_filler(const Params& p, int l, int part, char* shm) {
  const int G = ogdim(), c = obid();
  const int nwg = part == 0 ? 32 * (((l & 1) ? CD_IN : AB_IN) / 256) : 32 * (2 * FFN / 256);
  int first = idle_first(nwg, G), n = G - first;
  if (n == 0) { first = 0; n = G; }
  if (n > 128) { first += n - 128; n = 128; }
  if (c < first) return;
  const int tin = 32 * (((l & 1) ? CD_IN : AB_IN) / 256), o_out = tin, o_gate = tin + 256, o_down = tin + 256 + 1408, T = conv_ntiles(l);
  if (part == 0) conv_range(p, l, (l == 0 ? o_out : o_gate) + (c - first), o_down, n, shm);
  else { conv_range(p, l, o_down + (c - first), T, n, shm);
    if (l + 1 < DEPTH) { const int tin1 = 32 * ((((l + 1) & 1) ? CD_IN : AB_IN) / 256); conv_range(p, l + 1, c - first, tin1 + 256, n, shm); } }
}
__device__ __forceinline__ void phase_prologue(const Params& p, char* shm) {
  const int tid = otid(), bid = obid(), gdim = ogdim(), gtid = bid * 512 + tid, gsz = gdim * 512;
  for (int i = gtid; i < 7 * NTOK; i += gsz) p.sumsq()[NTOK + i] = 0ull;
  { const int wid = tid >> 6, lane = tid & 63;
    for (int row = bid * 8 + wid; row < NTOK; row += gdim * 8) { const float* xr = p.x + (size_t)row * DM; u16* brow = p.xb() + (size_t)row * DM; float ss = 0.f;
#pragma unroll
      for (int i = 0; i < 4; ++i) { const int c = (i * 64 + lane) * 8; const float4 a = *(const float4*)(xr + c), b = *(const float4*)(xr + c + 4);
        u32x4_t w = {pk2(a.x, a.y), pk2(a.z, a.w), pk2(b.x, b.y), pk2(b.z, b.w)}; *(u32x4_t*)(brow + c) = w;
        ss += a.x * a.x + a.y * a.y + a.z * a.z + a.w * a.w + b.x * b.x + b.y * b.y + b.z * b.z + b.w * b.w; }
#pragma unroll
      for (int s = 32; s >= 1; s >>= 1) ss += __shfl_xor(ss, s);
      if (lane == 0) p.sumsq()[row] = (unsigned long long)(ss * 16777216.0f); } }
  conv_range(p, 0, bid, 32 * (AB_IN / 256), gdim, shm);
}

__device__ __forceinline__ void phase_attn_even(const Params& p, int l, char* shm) {
  using at::bf16; const int j = l >> 1; const bf16* H = (const bf16*)p.h(); const long LD = AB_IN;
  for (int it = obid(); it < 512; it += ogdim()) {
    __syncthreads();
#ifndef SUBSEL
#define SUBSEL 3
#endif
    if (it < 256) { if (SUBSEL & 1) {
      const int xc = it & 7, jj = it >> 3, pr = xc >> 1, b = pr >> 1, hq = (pr & 1) * 4 + (jj & 3), qb = (xc & 1) * 8 + (jj >> 2); const long t0 = (long)b * SEQ;
      at::attn_body<at::PolNone, AB_IN, AB_IN, DM>(H + (t0 + qb * 256) * LD + 3072 + hq * 128, H + t0 * LD + 4096 + (hq >> 2) * 128, H + t0 * LD + 4352 + (hq >> 2) * 128,
                                 p.ao() + (size_t)(t0 + qb * 256) * DM + 1024 + hq * 128, 64, shm, at::PolNone{});
    } } else if (SUBSEL & 2) {
      const int i2 = it - 256, R = i2 & 15, hh = (i2 >> 4) & 7, b = i2 >> 7; const long t0 = (long)b * SEQ;
      float* rl = (float*)(shm + at::SHM_ATTN); const float* rg = p.a_rpb + (size_t)(j * 8 + hh) * 465;
      const int tq = otid(); for (int i = tq; i < 465; i += 512) rl[i] = rg[i];
      const int qi = (tq >> 6) * 32 + (tq & 31); const int rstart = min(max(4 * R - 4, 0), 52);
      at::PolNA pol{4 * R + (qi >> 6), qi & 63, rstart, rl};
      at::attn_body_simple<at::PolNA>(H + (t0 + R * 256) * LD + hh * 128, LD, H + (t0 + rstart * 64) * LD + 1024 + hh * 128, H + (t0 + rstart * 64) * LD + 2048 + hh * 128, LD,
                               p.ao() + (size_t)(t0 + R * 256) * DM + hh * 128, DM, 12, shm, pol, -INFINITY, nullptr, 0);
    }
  }
}
__device__ __forceinline__ void phase_attn_odd(const Params& p, int l, char* shm) {
  using at::bf16; const int j = l >> 1; const bf16* H = (const bf16*)p.h(); const long LD = CD_IN;
  for (int pos = obid(); pos < 768; pos += ogdim()) {
    __syncthreads();
    const int tq = otid(); const int qi = (tq >> 6) * 32 + (tq & 31);
    int it; { const int w = pos & 255, r = pos >> 8;
      if (r == 0) it = w; else if (r == 1) it = w < 128 ? 256 + w : 384 + (w - 128); else it = w < 128 ? 640 + w : 384 + 128 + (w - 128); }
    if (it < 384) {
      const int qb = it & 15, hq = (it >> 4) % 12, b = it / 192; const long t0 = (long)b * SEQ; const int q0 = qb * 256, ks = min(max(q0 - 128, 0), SEQ - 512), kv = hq / 3;
      at::PolWin pol{q0 + qi, ks, 128, q0 + (tq >> 6) * 32};
      at::attn_body_simple<at::PolWin>(H + (t0 + q0) * LD + hq * 128, LD, H + (t0 + ks) * LD + 1536 + kv * 128, H + (t0 + ks) * LD + 2048 + kv * 128, LD,
                                p.ao() + (size_t)(t0 + q0) * DM + hq * 128, DM, 8, shm, pol, p.c_sink[j * 12 + hq] * 1.4426950408889634f, nullptr, 0);
    } else {
      int e, g, s, b; if (it < 640) { const int i2 = it - 384; e = i2 & 15; g = (i2 >> 4) & 1; s = (i2 >> 5) & 3; b = i2 >> 7; } else { const int i2 = it - 640; e = i2 & 15; g = 2; s = (i2 >> 4) & 3; b = i2 >> 6; }
      const long t0 = (long)b * SEQ;
      const int d = g == 0 ? 1 : (g == 1 ? 4 : 16); const int rho = g == 0 ? 0 : (g == 1 ? (e >> 2) : e), ub = g == 0 ? e : (g == 1 ? (e & 3) : 0);
      const int sp = SEQ / d, u0 = ub * 256, nt = g == 2 ? 4 : 6, ks = min(max(u0 - 64, 0), sp - nt * 64);
      at::PolWin pol{u0 + qi, ks, 64, u0 + (tq >> 6) * 32};
      const long qtok = t0 + rho + (long)d * u0, ktok = t0 + rho + (long)d * ks;
      at::attn_body_simple<at::PolWin>(H + qtok * LD + 2560 + (g * 4 + s) * 128, LD * d, H + ktok * LD + 4096 + s * 128, H + ktok * LD + 4608 + s * 128, LD * d,
                                p.dpart() + ((size_t)g * NTOK + qtok) * 512 + s * 128, 512L * d, nt, shm, pol, -INFINITY,
                                p.dml() + (((size_t)g * NTOK + qtok) * 4 + s) * 2, 8L * d);
    }
  }
}
__device__ __forceinline__ void phase_merge(const Params& p) {
  const int tid = otid(), lj = tid & 15;
  constexpr int U = 4;
  for (int rid0 = obid() * (32 * U) + (tid >> 4); rid0 < NTOK * 4; rid0 += ogdim() * (32 * U)) {
    float2 ml[U][3]; u32x4_t raw[U][3];
#pragma unroll
    for (int u = 0; u < U; ++u) { const int rid = rid0 + 32 * u, tok = rid >> 2, s = rid & 3;
#pragma unroll
      for (int g = 0; g < 3; ++g) { ml[u][g] = *(const float2*)(p.dml() + (((size_t)g * NTOK + tok) * 4 + s) * 2);
        raw[u][g] = *(const u32x4_t*)(p.dpart() + ((size_t)g * NTOK + tok) * 512 + s * 128 + lj * 8); } }
#pragma unroll
    for (int u = 0; u < U; ++u) { const int rid = rid0 + 32 * u, tok = rid >> 2, s = rid & 3;
      const float M = fmaxf(ml[u][0].x, fmaxf(ml[u][1].x, ml[u][2].x)); float w[3], ws = 0.f;
#pragma unroll
      for (int g = 0; g < 3; ++g) { w[g] = __builtin_amdgcn_exp2f(ml[u][g].x - M) * ml[u][g].y; ws += w[g]; }
      const float inv = 1.0f / ws; float acc[8] = {0.f, 0.f, 0.f, 0.f, 0.f, 0.f, 0.f, 0.f};
#pragma unroll
      for (int g = 0; g < 3; ++g) { const float wg = w[g] * inv;
#pragma unroll
        for (int e = 0; e < 4; ++e) { acc[2 * e] += wg * __uint_as_float(raw[u][g][e] << 16); acc[2 * e + 1] += wg * __uint_as_float(raw[u][g][e] & 0xffff0000u); } }
      u32x4_t o = {pk2(acc[0], acc[1]), pk2(acc[2], acc[3]), pk2(acc[4], acc[5]), pk2(acc[6], acc[7])};
      *(u32x4_t*)(p.ao() + (size_t)tok * DM + 1536 + s * 128 + lj * 8) = o; }
  }
}

template <class Epi> __device__ __forceinline__ void run_gemm(const u16* A, const u16* Bt, int N, int K, const Epi& E, char* shm) {
  pg8::Gemm g{A, Bt, NTOK, N, K}; pg8::StaticOrder S; S.init(NTOK, N, ogdim(), obid());
  pg8::gemm_phase<Epi, pg8::StaticOrder, false>((PG8_LAS unsigned char*)shm, g, S, E, nullptr);
}

__device__ __forceinline__ Params load_params() {
  const __attribute__((address_space(4))) Params* q = (const __attribute__((address_space(4))) Params*)__builtin_amdgcn_kernarg_segment_ptr();
  asm volatile("" : "+s"(q));
#if defined(__HIP_DEVICE_COMPILE__)
  return *q;
#else
  return Params{};
#endif
}
constexpr int NPHASE = 1 + 7 * DEPTH;
__global__ void __launch_bounds__(512) mega(Params p_unused) {
  extern __shared__ __attribute__((aligned(16))) char shm[];
  cg::grid_group grid = cg::this_grid();
  if (load_params().ws == nullptr) grid.sync();
  volatile LAS unsigned* xst = (volatile LAS unsigned*)(shm + 131072 + 2048);
  if (threadIdx.x < 4) xst[threadIdx.x] = 0u;
  __syncthreads();
  const XcdBarrier xbar = xcd_barrier_post(load_params().bar(), xst);
  { const Params p = load_params(); phase_prologue(p, shm); }
  xcd_barrier(xbar);
  for (int l = 0; l < DEPTH; ++l) {
    const bool odd = l & 1; const int nin = odd ? CD_IN : AB_IN;
    { const Params p = load_params(); const int j = l >> 1;
      run_gemm(p.xb(), p.wt_in() + l * WT_IN_L, nin, DM, pg8::EpiHN{p.h(), nin, p.sumsq() + (2 * l) * NTOK, (odd ? p.c_qn : p.a_qn) + j * 128, (odd ? p.c_kn : p.a_kn) + j * 128,
               (odd ? p.d_qn : p.b_qn) + j * 128, (odd ? p.d_kn : p.b_kn) + j * 128, odd ? 1 : 0, (PG8_LAS float*)(shm + 131072 + 4096)}, shm);
      conv_filler(p, l, 0, shm); }
    xcd_barrier(xbar);
    { const Params p = load_params(); if (odd) phase_attn_odd(p, l, shm); else phase_attn_even(p, l, shm); }
    xcd_barrier(xbar);
    if (odd) { { const Params p = load_params(); phase_merge(p); } xcd_barrier(xbar); }
    { const Params p = load_params(); run_gemm(p.ao(), p.wt_out() + l * WT_OUT_L, DM, DM, pg8::EpiResT<false>{nullptr, p.xb(), p.sumsq() + (2 * l + 1) * NTOK}, shm); }
    xcd_barrier(xbar);
    { const Params p = load_params(); run_gemm(p.xb(), p.wt_gu() + l * WT_GU_L, 2 * FFN, DM, pg8::EpiGU{p.hid(), p.sumsq() + (2 * l + 1) * NTOK}, shm); conv_filler(p, l, 1, shm); }
    xcd_barrier(xbar);
    { const Params p = load_params();
      if (l + 1 < DEPTH) run_gemm(p.hid(), p.wt_dn() + l * WT_DN_L, DM, FFN, pg8::EpiResT<false>{nullptr, p.xb(), p.sumsq() + (2 * l + 2) * NTOK}, shm);
      else run_gemm(p.hid(), p.wt_dn() + l * WT_DN_L, DM, FFN, pg8::EpiResT<true>{p.xres, p.xb(), nullptr}, shm); }
    if (l + 1 < DEPTH) xcd_barrier(xbar);
  }
}

extern "C" void kernel_launch(void* const* d_in, const int* in_sizes, int n_in, void* d_out, int out_size, void* d_ws, size_t ws_size, hipStream_t stream) {
  Params p; memset(&p, 0, sizeof(p));
  const float** pf = (const float**)&p;
  for (int i = 0; i < 20; ++i) pf[i] = (const float*)d_in[i];
  p.xres = (float*)d_out;
  p.ws = (char*)d_ws; const size_t off = WS_END;
  static int grid_blocks = 0;
  if (!grid_blocks) {
    if (off > ws_size) { fprintf(stderr, "kernel_launch: ws too small: need %zu have %zu\n", off, ws_size); return; }
    if (hipFuncSetAttribute((const void*)mega, hipFuncAttributeMaxDynamicSharedMemorySize, LDS_BYTES) != hipSuccess) { fprintf(stderr, "kernel_launch: LDS attribute failed\n"); return; }
    int dev = 0, cus = 0, per_cu = 0; hipGetDevice(&dev); hipDeviceGetAttribute(&cus, hipDeviceAttributeMultiprocessorCount, dev);
    hipOccupancyMaxActiveBlocksPerMultiprocessor(&per_cu, mega, 512, LDS_BYTES);
    if (per_cu < 1) { fprintf(stderr, "kernel_launch: occupancy 0\n"); return; }
    grid_blocks = cus;
  }
  hipMemsetAsync((char*)d_ws + O_BAR, 0, (size_t)XCD_BAR_WORDS * 4, stream);
  void* args[] = {&p};
  hipError_t e = hipLaunchCooperativeKernel((const void*)mega, dim3(grid_blocks), dim3(512), args, LDS_BYTES, stream);
  if (e != hipSuccess) fprintf(stderr, "cooperative launch failed: %s (grid %d)\n", hipGetErrorString(e), grid_blocks);
}
```
